# Optimizing an MI355X kernel written in HIP

```python
import jax, jax.numpy as jnp
from jax import lax
import numpy as np

D_MODEL = 1024
BATCH = 2
SEQ = 8192
DEPTH = 1

D_MIX = D_MODEL
ROPE_THETA = 500000.0
Q_BLOCK = 128
NSA_HEADS = 8
NSA_KV_GROUPS = 2
NSA_HPG = NSA_HEADS // NSA_KV_GROUPS
NSA_HEAD_DIM = 64
NSA_ROPE_DIM = NSA_HEAD_DIM // 4
CMP_BLOCK = 32
CMP_STRIDE = 16
CMP_HIDDEN = 4 * NSA_HEAD_DIM
SLC_BLOCK = 64
SLC_TOPK = 16
WINDOW = 512
FORCE_SCORE = 1e9
MLA_HEADS = 8
MLA_NOPE_DIM = 64
MLA_ROPE_DIM = 32
MLA_V_DIM = 64
MLA_Q_RANK = 384
MLA_KV_RANK = 256
D_FF = 2816
ALPHA = (2.0 * DEPTH) ** 0.25
BETA = (8.0 * DEPTH) ** -0.25
N_MOD = 9
EPS = 1e-5

NSA_Q = NSA_HEADS * NSA_HEAD_DIM
NSA_KV = NSA_KV_GROUPS * NSA_HEAD_DIM
NSA_GATE = 3 * NSA_HEADS
IN_SIZES = [NSA_Q] + [NSA_KV] * 6 + [NSA_GATE, MLA_Q_RANK, MLA_KV_RANK, MLA_ROPE_DIM]
D_IN = sum(IN_SIZES)

kernel_name = "hymba_nsa_mla_macaron_deepnorm_adaln"


def layer_norm(x, g, b):
    xf = x.astype(jnp.float32)
    mu = jnp.mean(xf, -1, keepdims=True)
    var = jnp.mean(jnp.square(xf - mu), -1, keepdims=True)
    return ((xf - mu) * lax.rsqrt(var + EPS) * g + b).astype(x.dtype)


def rms_norm(x, g):
    xf = x.astype(jnp.float32)
    return (xf * lax.rsqrt(jnp.mean(xf * xf, -1, keepdims=True) + EPS) * g).astype(x.dtype)


def rope(x, pos, dim):
    half = dim // 2
    inv = ROPE_THETA ** (-jnp.arange(half, dtype=jnp.float32) / half)
    ang = pos.astype(jnp.float32)[:, None] * inv[None, :]
    cos = jnp.cos(ang).astype(x.dtype)
    sin = jnp.sin(ang).astype(x.dtype)
    x1, x2, rest = x[..., :half], x[..., half:dim], x[..., dim:]
    return jnp.concatenate([x1 * cos - x2 * sin, x2 * cos + x1 * sin, rest], axis=-1)


def masked_softmax(s, mask):
    s = jnp.where(mask, s.astype(jnp.float32), -jnp.inf)
    m = jnp.max(s, -1, keepdims=True)
    m = jnp.where(jnp.isfinite(m), m, 0.0)
    e = jnp.where(mask, jnp.exp(s - m), 0.0)
    return e / jnp.maximum(jnp.sum(e, -1, keepdims=True), 1e-30)


def swiglu(u, wg, wu, wd):
    return (jax.nn.silu(u @ wg) * (u @ wu)) @ wd


def compress(kv, pos_emb, w1, w2):
    T = kv.shape[2]
    n_cmp = (T - CMP_BLOCK) // CMP_STRIDE + 1
    idx = np.arange(n_cmp)[:, None] * CMP_STRIDE + np.arange(CMP_BLOCK)[None, :]
    blocks = kv[:, :, idx] + pos_emb
    flat = blocks.reshape(blocks.shape[:3] + (CMP_BLOCK * NSA_HEAD_DIM,))
    return jax.nn.gelu(flat @ w1) @ w2


def gather_blocks(blocks, idx):
    return jax.vmap(jax.vmap(lambda kb, ix: kb[ix]))(blocks, idx)


def nsa_mixer(q, kc, vc, ks, vs, kw, vw, gate_logits, pos,
              cmp_k_pos, cmp_k_w1, cmp_k_w2, cmp_v_pos, cmp_v_w1, cmp_v_w2):
    B, T, _ = q.shape
    nb = T // Q_BLOCK
    scale = NSA_HEAD_DIM ** -0.5
    q = q.reshape(B, T, NSA_KV_GROUPS, NSA_HPG, NSA_HEAD_DIM).transpose(0, 2, 3, 1, 4)
    q = rope(q, pos, NSA_ROPE_DIM)
    gates = jax.nn.sigmoid(gate_logits.reshape(B, T, NSA_KV_GROUPS, NSA_HPG, 3).transpose(0, 2, 3, 1, 4))

    def kv_heads(a):
        return a.reshape(B, T, NSA_KV_GROUPS, NSA_HEAD_DIM).transpose(0, 2, 1, 3)

    kc, vc, ks, vs, kw, vw = [kv_heads(a) for a in (kc, vc, ks, vs, kw, vw)]
    kc, ks, kw = rope(kc, pos, NSA_ROPE_DIM), rope(ks, pos, NSA_ROPE_DIM), rope(kw, pos, NSA_ROPE_DIM)

    k_cmp = compress(kc, cmp_k_pos, cmp_k_w1, cmp_k_w2)
    v_cmp = compress(vc, cmp_v_pos, cmp_v_w1, cmp_v_w2)
    n_cmp = k_cmp.shape[2]
    cmp_start = np.arange(n_cmp) * CMP_STRIDE
    cmp_end = jnp.asarray(cmp_start + CMP_BLOCK - 1)
    n_slc = T // SLC_BLOCK
    n_sel = min(SLC_TOPK, n_slc)
    slc_start = np.arange(n_slc) * SLC_BLOCK
    overlap = jnp.asarray(((cmp_start[:, None] < slc_start[None, :] + SLC_BLOCK) &
                           (cmp_start[:, None] + CMP_BLOCK > slc_start[None, :])).astype(np.float32))
    ks_blk = ks.reshape(B, NSA_KV_GROUPS, n_slc, SLC_BLOCK, NSA_HEAD_DIM)
    vs_blk = vs.reshape(B, NSA_KV_GROUPS, n_slc, SLC_BLOCK, NSA_HEAD_DIM)
    pad = ((0, 0), (0, 0), (WINDOW, 0), (0, 0))
    kw_pad, vw_pad = jnp.pad(kw, pad), jnp.pad(vw, pad)
    jj = jnp.arange(n_slc)

    def block(args):
        i, qb, gb = args
        t = i * Q_BLOCK + jnp.arange(Q_BLOCK)
        s = jnp.einsum('bghqd,bgnd->bghqn', qb, k_cmp) * scale
        p_cmp = masked_softmax(s, cmp_end[None, :] <= t[:, None])
        o_cmp = jnp.einsum('bghqn,bgnd->bghqd', p_cmp.astype(v_cmp.dtype), v_cmp)
        imp = jnp.einsum('bghqn,nj->bgqj', p_cmp, overlap)
        cur = t // SLC_BLOCK
        causal_blk = (jj[None, :] * SLC_BLOCK) <= t[:, None]
        forced = (jj[None, :] == 0) | (jj[None, :] == cur[:, None]) | (jj[None, :] == cur[:, None] - 1)
        imp = jnp.where(forced & causal_blk, FORCE_SCORE, jnp.where(causal_blk, imp, -1.0))
        _, sel = lax.top_k(imp, n_sel)
        k_sel = gather_blocks(ks_blk, sel).reshape(B, NSA_KV_GROUPS, Q_BLOCK, n_sel * SLC_BLOCK, NSA_HEAD_DIM)
        v_sel = gather_blocks(vs_blk, sel).reshape(B, NSA_KV_GROUPS, Q_BLOCK, n_sel * SLC_BLOCK, NSA_HEAD_DIM)
        sel_pos = (sel[..., None] * SLC_BLOCK + jnp.arange(SLC_BLOCK)).reshape(B, NSA_KV_GROUPS, Q_BLOCK, n_sel * SLC_BLOCK)
        m_sel = (sel_pos <= t[None, None, :, None])[:, :, None]
        s = jnp.einsum('bghqd,bgqkd->bghqk', qb, k_sel) * scale
        p_sel = masked_softmax(s, m_sel)
        o_sel = jnp.einsum('bghqk,bgqkd->bghqd', p_sel.astype(v_sel.dtype), v_sel)
        kwb = lax.dynamic_slice_in_dim(kw_pad, i * Q_BLOCK, WINDOW + Q_BLOCK, axis=2)
        vwb = lax.dynamic_slice_in_dim(vw_pad, i * Q_BLOCK, WINDOW + Q_BLOCK, axis=2)
        s_pos = i * Q_BLOCK - WINDOW + jnp.arange(WINDOW + Q_BLOCK)
        diff = t[:, None] - s_pos[None, :]
        m_win = (s_pos[None, :] >= 0) & (diff >= 0) & (diff < WINDOW)
        s = jnp.einsum('bghqd,bgkd->bghqk', qb, kwb) * scale
        p_win = masked_softmax(s, m_win)
        o_win = jnp.einsum('bghqk,bgkd->bghqd', p_win.astype(vwb.dtype), vwb)
        gb = gb.astype(qb.dtype)
        return gb[..., 0:1] * o_cmp + gb[..., 1:2] * o_sel + gb[..., 2:3] * o_win

    qbs = jnp.moveaxis(q.reshape(B, NSA_KV_GROUPS, NSA_HPG, nb, Q_BLOCK, NSA_HEAD_DIM), 3, 0)
    gbs = jnp.moveaxis(gates.reshape(B, NSA_KV_GROUPS, NSA_HPG, nb, Q_BLOCK, 3), 3, 0)
    out = lax.map(block, (jnp.arange(nb), qbs, gbs))
    out = jnp.moveaxis(out, 0, 3).reshape(B, NSA_KV_GROUPS, NSA_HPG, T, NSA_HEAD_DIM)
    return out.transpose(0, 3, 1, 2, 4).reshape(B, T, NSA_HEADS * NSA_HEAD_DIM)


def mla_mixer(cq, ckv, k_rope, pos, q_norm_g, kv_norm_g, w_uq, w_ukv):
    B, T, _ = cq.shape
    nb = T // Q_BLOCK
    scale = (MLA_NOPE_DIM + MLA_ROPE_DIM) ** -0.5
    q = (rms_norm(cq, q_norm_g) @ w_uq).reshape(B, T, MLA_HEADS, MLA_NOPE_DIM + MLA_ROPE_DIM).transpose(0, 2, 1, 3)
    q_nope, q_rope = q[..., :MLA_NOPE_DIM], rope(q[..., MLA_NOPE_DIM:], pos, MLA_ROPE_DIM)
    kv = (rms_norm(ckv, kv_norm_g) @ w_ukv).reshape(B, T, MLA_HEADS, MLA_NOPE_DIM + MLA_V_DIM).transpose(0, 2, 1, 3)
    k_nope, v = kv[..., :MLA_NOPE_DIM], kv[..., MLA_NOPE_DIM:]
    k_rope = rope(k_rope, pos, MLA_ROPE_DIM)
    key_pos = jnp.arange(T)

    def block(args):
        i, qn, qr = args
        t = i * Q_BLOCK + jnp.arange(Q_BLOCK)
        s = (jnp.einsum('bhqd,bhkd->bhqk', qn, k_nope) + jnp.einsum('bhqd,bkd->bhqk', qr, k_rope)) * scale
        p = masked_softmax(s, key_pos[None, :] <= t[:, None])
        return jnp.einsum('bhqk,bhkd->bhqd', p.astype(v.dtype), v)

    qn_b = jnp.moveaxis(q_nope.reshape(B, MLA_HEADS, nb, Q_BLOCK, MLA_NOPE_DIM), 2, 0)
    qr_b = jnp.moveaxis(q_rope.reshape(B, MLA_HEADS, nb, Q_BLOCK, MLA_ROPE_DIM), 2, 0)
    out = lax.map(block, (jnp.arange(nb), qn_b, qr_b))
    out = jnp.moveaxis(out, 0, 2).reshape(B, MLA_HEADS, T, MLA_V_DIM)
    return out.transpose(0, 2, 1, 3).reshape(B, T, MLA_HEADS * MLA_V_DIM)


def setup_inputs(seed: int = 0) -> dict:
    key = jax.random.key(seed)
    ks = jax.random.split(key, 24)
    n = lambda k, shape, s: jax.random.normal(k, shape, jnp.float32) * s
    L = DEPTH
    return {
        "x": n(ks[0], (BATCH, SEQ, D_MODEL), 1.0),
        "c": n(ks[1], (BATCH, D_MODEL), 1.0),
        "w_ada": n(ks[2], (L, D_MODEL, N_MOD * D_MODEL), 0.25 * D_MODEL ** -0.5),
        "b_ada": n(ks[3], (L, N_MOD * D_MODEL), 0.01),
        "ln_g": 1.0 + n(ks[4], (L, 3, D_MODEL), 0.02),
        "ln_b": n(ks[5], (L, 3, D_MODEL), 0.02),
        "ffn1_wg": n(ks[6], (L, D_MODEL, D_FF), D_MODEL ** -0.5),
        "ffn1_wu": n(ks[7], (L, D_MODEL, D_FF), D_MODEL ** -0.5),
        "ffn1_wd": n(ks[8], (L, D_FF, D_MODEL), BETA * D_FF ** -0.5),
        "w_in": n(ks[9], (L, D_MODEL, D_IN), D_MODEL ** -0.5),
        "cmp_k_pos": n(ks[10], (L, CMP_BLOCK, NSA_HEAD_DIM), 0.02),
        "cmp_k_w1": n(ks[11], (L, CMP_BLOCK * NSA_HEAD_DIM, CMP_HIDDEN), (CMP_BLOCK * NSA_HEAD_DIM) ** -0.5),
        "cmp_k_w2": n(ks[12], (L, CMP_HIDDEN, NSA_HEAD_DIM), CMP_HIDDEN ** -0.5),
        "cmp_v_pos": n(ks[13], (L, CMP_BLOCK, NSA_HEAD_DIM), 0.02),
        "cmp_v_w1": n(ks[14], (L, CMP_BLOCK * NSA_HEAD_DIM, CMP_HIDDEN), (CMP_BLOCK * NSA_HEAD_DIM) ** -0.5),
        "cmp_v_w2": n(ks[15], (L, CMP_HIDDEN, NSA_HEAD_DIM), CMP_HIDDEN ** -0.5),
        "mla_q_norm": 1.0 + n(ks[16], (L, MLA_Q_RANK), 0.02),
        "mla_kv_norm": 1.0 + n(ks[17], (L, MLA_KV_RANK), 0.02),
        "mla_w_uq": n(ks[18], (L, MLA_Q_RANK, MLA_HEADS * (MLA_NOPE_DIM + MLA_ROPE_DIM)), MLA_Q_RANK ** -0.5),
        "mla_w_ukv": n(ks[19], (L, MLA_KV_RANK, MLA_HEADS * (MLA_NOPE_DIM + MLA_V_DIM)), MLA_KV_RANK ** -0.5),
        "w_out": n(ks[20], (L, D_MIX, D_MODEL), BETA * D_MIX ** -0.5),
        "ffn2_wg": n(ks[21], (L, D_MODEL, D_FF), D_MODEL ** -0.5),
        "ffn2_wu": n(ks[22], (L, D_MODEL, D_FF), D_MODEL ** -0.5),
        "ffn2_wd": n(ks[23], (L, D_FF, D_MODEL), BETA * D_FF ** -0.5),
    }


def reference(x, c, w_ada, b_ada, ln_g, ln_b, ffn1_wg, ffn1_wu, ffn1_wd, w_in,
              cmp_k_pos, cmp_k_w1, cmp_k_w2, cmp_v_pos, cmp_v_w1, cmp_v_w2,
              mla_q_norm, mla_kv_norm, mla_w_uq, mla_w_ukv, w_out,
              ffn2_wg, ffn2_wu, ffn2_wd):
    T = x.shape[1]
    pos = jnp.arange(T)
    split_at = [int(v) for v in np.cumsum(IN_SIZES)[:-1]]
    for l in range(DEPTH):
        mod = jax.nn.silu(c) @ w_ada[l] + b_ada[l]
        sh1, sc1, g1, sh2, sc2, g2, sh3, sc3, g3 = jnp.split(mod[:, None, :], N_MOD, axis=-1)
        u = x * (1.0 + sc1) + sh1
        x = layer_norm(ALPHA * x + 0.5 * (1.0 + g1) * swiglu(u, ffn1_wg[l], ffn1_wu[l], ffn1_wd[l]), ln_g[l, 0], ln_b[l, 0])
        u = x * (1.0 + sc2) + sh2
        h = u @ w_in[l]
        q_a, kc, vc, ksl, vsl, kwn, vwn, gate_logits, cq, ckv, k_rope = jnp.split(h, split_at, axis=-1)
        o_nsa = nsa_mixer(q_a, kc, vc, ksl, vsl, kwn, vwn, gate_logits, pos,
                          cmp_k_pos[l], cmp_k_w1[l], cmp_k_w2[l], cmp_v_pos[l], cmp_v_w1[l], cmp_v_w2[l])
        o_mla = mla_mixer(cq, ckv, k_rope, pos, mla_q_norm[l], mla_kv_norm[l], mla_w_uq[l], mla_w_ukv[l])
        y = jnp.concatenate([o_nsa, o_mla], axis=-1) @ w_out[l]
        x = layer_norm(ALPHA * x + (1.0 + g2) * y, ln_g[l, 1], ln_b[l, 1])
        u = x * (1.0 + sc3) + sh3
        x = layer_norm(ALPHA * x + 0.5 * (1.0 + g3) * swiglu(u, ffn2_wg[l], ffn2_wu[l], ffn2_wd[l]), ln_g[l, 2], ln_b[l, 2])
    return x
```

```cpp
#include <hip/hip_runtime.h>
#include <hip/hip_cooperative_groups.h>
#include <cstdio>
#include <cstdint>
#include <cmath>
namespace cg = cooperative_groups;
namespace pg8 {
#define PG8_LAS __attribute__((address_space(3)))
typedef unsigned short bf16_t;
typedef short bf16x8 __attribute__((ext_vector_type(8)));
typedef float f32x4 __attribute__((ext_vector_type(4)));
typedef unsigned u32x4 __attribute__((ext_vector_type(4)));
constexpr int BM = 256, BK = 64, HALF = 128, HTB = HALF * BK * 2  , STAGE_BYTES = 8 * HTB, NXCD = 8, WGM = 8;

__host__ __device__ __forceinline__ int lds_byte(int r, int c) { const int st = (r >> 4) * 2 + (c >> 5), rr = r & 15, cc = c & 31, ob = rr * 64 + cc * 2; return st * 1024 + (ob ^ (((ob >> 9) & 1) << 5)); }
__host__ __device__ __forceinline__ void stage_rc(int b, int& R, int& C) { const int st = b / 1024, sb = b % 1024, swz = sb ^ (((sb >> 9) & 1) << 5); R = (st >> 1) * 16 + swz / 64; C = (st & 1) * 32 + (swz % 64) / 2; }
__host__ __device__ __forceinline__ int perm32(int rho) { const int n = rho >> 4, i = rho & 15; return 8 * (i >> 2) + 4 * n + (i & 3); }

struct Unit { int pm, pn; };
struct Gemm { const bf16_t* A; const bf16_t* Bt; int M, N, K; };

struct StaticOrder {
    int nM, nN, nwg, G, c;
    __host__ __device__ void init(int M, int N, int G_, int c_) { nM = M / BM; nN = N / BM; nwg = nM * nN; G = G_; c = c_; }
    __host__ __device__ bool next(int i, Unit& u) const {
        const long L = (long)i * G + c; if (L >= nwg) return false;
        int wgid = (int)L; { const int q = nwg / NXCD, r = nwg % NXCD, xcd = wgid % NXCD, off = wgid / NXCD; wgid = (xcd < r ? xcd * (q + 1) : r * (q + 1) + (xcd - r) * q) + off; }
        const int nig = WGM * nN, gid = wgid / nig, fm = gid * WGM, gsz = (nM - fm) < WGM ? (nM - fm) : WGM;
        u.pm = fm + ((wgid % nig) % gsz); u.pn = (wgid % nig) / gsz; return true;
    }
    __device__ __forceinline__ void a_ready(const Unit&) const {}
    __device__ __forceinline__ void done(const Unit&) const {}
};

__device__ __forceinline__ unsigned cvt_pk_bf16(float lo, float hi) { unsigned r; asm volatile("v_cvt_pk_bf16_f32 %0, %1, %2" : "=v"(r) : "v"(lo), "v"(hi)); return r; }
typedef float f32x2 __attribute__((ext_vector_type(2)));
__device__ __forceinline__ f32x2 gelu_pk(f32x2 v) {
    const f32x2 av = __builtin_elementwise_abs(v), d = av * 0.2316418882f + 1.0f;
    f32x2 t; t.x = __builtin_amdgcn_rcpf(d.x); t.y = __builtin_amdgcn_rcpf(d.y);
    f32x2 q = t * 0.5307027145f + (-0.7265760135f); q = q * t + 0.7107068705f; q = q * t + (-0.142248368f); q = q * t + 0.127414796f; q = q * t;
    const f32x2 s = (v * v) * (-0.72134752044f);
    f32x2 e; e.x = __builtin_amdgcn_exp2f(s.x); e.y = __builtin_amdgcn_exp2f(s.y);
    const f32x2 m = v * (q * e), r = v - m;
    f32x2 o; o.x = v.x < 0.f ? m.x : r.x; o.y = v.y < 0.f ? m.y : r.y; return o;
}

template <int ACT  > struct EpiBf16 {
    static constexpr bool PERM = true, AFTER_DRAIN = false; static_assert(ACT == 0 || ACT == 1, "EpiBf16: ACT is 0 (none) or 1 (gelu_pk)");
    bf16_t* O; int ldc; const float* bias; int split_cols; size_t split_stride; float scale0;
    __device__ __forceinline__ void operator()(const f32x4 (&acc)[2][2][4][2], const Unit& u, int wr, int wc, int fr, int fq) const {
        const int row0 = u.pm * BM + wr * 64 + fr; int colt = u.pn * BM; bf16_t* base = O;
        float sc = 1.f; if (split_cols) { const int t = colt / split_cols; base += (size_t)t * split_stride; colt -= t * split_cols; if (t == 0) sc = scale0; }
        const int col0 = colt + wc * 32 + 8 * fq, bcol0 = u.pn * BM + wc * 32 + 8 * fq;
        f32x4 bv[2][2];
#pragma unroll
        for (int bj = 0; bj < 2; ++bj)
#pragma unroll
            for (int n = 0; n < 2; ++n) bv[bj][n] = bias ? *(const f32x4*)(bias + bcol0 + bj * HALF + 4 * n) : (f32x4){0.f, 0.f, 0.f, 0.f};
#pragma unroll
        for (int ai = 0; ai < 2; ++ai)
#pragma unroll
            for (int m = 0; m < 4; ++m) { bf16_t* rowp = base + (size_t)(row0 + ai * HALF + m * 16) * ldc + col0;
#pragma unroll
                for (int bj = 0; bj < 2; ++bj) { f32x4 v0 = acc[ai][bj][m][0] + bv[bj][0], v1 = acc[ai][bj][m][1] + bv[bj][1];
                    if (ACT == 1) { f32x2 a = gelu_pk((f32x2){v0[0], v0[1]}), b = gelu_pk((f32x2){v0[2], v0[3]}), c = gelu_pk((f32x2){v1[0], v1[1]}), d = gelu_pk((f32x2){v1[2], v1[3]});
                        v0 = (f32x4){a.x, a.y, b.x, b.y}; v1 = (f32x4){c.x, c.y, d.x, d.y}; }
                    v0 = v0 * sc; v1 = v1 * sc; u32x4 w; w.x = cvt_pk_bf16(v0[0], v0[1]); w.y = cvt_pk_bf16(v0[2], v0[3]); w.z = cvt_pk_bf16(v1[0], v1[1]); w.w = cvt_pk_bf16(v1[2], v1[3]);
                    *(u32x4*)(rowp + bj * HALF) = w; } }
    }
};
template <class Epi, class Sched, bool ALIGN_EPI = false, bool SP2 = false>
__device__ __forceinline__ void gemm_phase(PG8_LAS unsigned char* lds, const Gemm g, const Sched& S, const Epi& E) {
    const int tid = threadIdx.x, wid = __builtin_amdgcn_readfirstlane(tid >> 6), lane = tid & 63, wr = wid >> 2, wc = wid & 3, fr = lane & 15, fq = lane >> 4;
    const int K = g.K, nt = K / BK;
    unsigned voffA[2], voffB[2];
#pragma unroll
    for (int i = 0; i < 2; ++i) { int R, C; stage_rc(tid * 16 + i * 8192, R, C); const int Rb = Epi::PERM ? ((R & ~31) + perm32(R & 31)) : R;
        voffA[i] = (unsigned)(R * K + C) * 2u; voffB[i] = (unsigned)(Rb * K + C) * 2u; }
    const size_t kstep = (size_t)(BK * 2);
    const size_t hstep = (size_t)HALF * K * 2;
    const size_t tstep = 2 * hstep;
    const unsigned ldsw = (unsigned)wid * 1024u;
    const int aoff = lds_byte(wr * 64 + fr, fq * 8), boff = lds_byte(wc * 32 + fr, fq * 8);
#define PG8_SA(b, h) (((b) * 2 + (h)) * HTB)
#define PG8_SB(b, h) ((4 + (b) * 2 + (h)) * HTB)
#define PG8_STAGE(bufoff, gbase, voff) do { _Pragma("unroll") for (int _i = 0; _i < 2; ++_i) \
        __builtin_amdgcn_global_load_lds((const unsigned*)((const char*)(gbase) + (voff)[_i]), (PG8_LAS unsigned*)(lds + (bufoff) + ldsw + _i * 8192), 16, 0, 0); } while (0)
#define PG8_LDA(dst, b, h) do { _Pragma("unroll") for (int m = 0; m < 4; ++m) _Pragma("unroll") for (int k = 0; k < 2; ++k) dst[m][k] = *(const PG8_LAS bf16x8*)(lds + PG8_SA(b, h) + aoff + m * 2048 + k * 1024); } while (0)
#define PG8_LDB(dst, b, h) do { _Pragma("unroll") for (int n = 0; n < 2; ++n) _Pragma("unroll") for (int k = 0; k < 2; ++k) dst[n][k] = *(const PG8_LAS bf16x8*)(lds + PG8_SB(b, h) + boff + n * 2048 + k * 1024); } while (0)
#define PG8_MMA(ai, bj, At, Bt) do { __builtin_amdgcn_s_setprio(1); _Pragma("unroll") for (int m = 0; m < 4; ++m) _Pragma("unroll") for (int n = 0; n < 2; ++n) _Pragma("unroll") for (int k = 0; k < 2; ++k) \
        acc[ai][bj][m][n] = __builtin_amdgcn_mfma_f32_16x16x32_bf16(Bt[n][k], At[m][k], acc[ai][bj][m][n], 0, 0, 0); __builtin_amdgcn_s_setprio(0); } while (0)
#define PG8_WAIT_V(n) asm volatile("s_waitcnt vmcnt(" #n ")" ::: "memory")
#define PG8_WAIT_L(n) asm volatile("s_waitcnt lgkmcnt(" #n ")" ::: "memory")
#define PG8_BAR __builtin_amdgcn_s_barrier()
#define PG8_SCHED __builtin_amdgcn_sched_barrier(0)
    Unit cur, nxt; int ui = 0;
    if (!S.next(0, cur)) return;
    f32x4 acc[2][2][4][2];
#pragma unroll
    for (int a = 0; a < 2; ++a)
#pragma unroll
        for (int b = 0; b < 2; ++b)
#pragma unroll
            for (int m = 0; m < 4; ++m)
#pragma unroll
                for (int n = 0; n < 2; ++n) acc[a][b][m][n] = (f32x4){0.f, 0.f, 0.f, 0.f};
    bf16x8 At[4][2], B0[2][2], B1[2][2];
    const char* cA = (const char*)g.A + (size_t)cur.pm * tstep; const char* cB = (const char*)g.Bt + (size_t)cur.pn * tstep;
    S.a_ready(cur);
    if constexpr (SP2) {
        PG8_STAGE(PG8_SB(0, 0), cB, voffB); PG8_STAGE(PG8_SB(0, 1), cB + hstep, voffB); PG8_STAGE(PG8_SA(0, 0), cA, voffA); PG8_STAGE(PG8_SA(0, 1), cA + hstep, voffA);
        if (wr == 1) PG8_BAR;
        PG8_WAIT_V(2); PG8_BAR;
        PG8_STAGE(PG8_SB(1, 0), cB + kstep, voffB); PG8_STAGE(PG8_SA(1, 0), cA + kstep, voffA); PG8_STAGE(PG8_SB(1, 1), cB + hstep + kstep, voffB);
        PG8_WAIT_V(6); PG8_BAR;
    } else {
        PG8_STAGE(PG8_SB(0, 0), cB, voffB); PG8_STAGE(PG8_SA(0, 0), cA, voffA); PG8_STAGE(PG8_SB(0, 1), cB + hstep, voffB); PG8_STAGE(PG8_SA(0, 1), cA + hstep, voffA);
        if (wr == 1) PG8_BAR;
        PG8_WAIT_V(4); PG8_BAR;
        PG8_STAGE(PG8_SB(1, 0), cB + kstep, voffB); PG8_STAGE(PG8_SA(1, 0), cA + kstep, voffA); PG8_STAGE(PG8_SB(1, 1), cB + hstep + kstep, voffB);
        PG8_WAIT_V(6); PG8_BAR;
    }
    for (;;) {
        const bool has_next = S.next(ui + 1, nxt);
        const char* nA = has_next ? (const char*)g.A + (size_t)nxt.pm * tstep : cA; const char* nB = has_next ? (const char*)g.Bt + (size_t)nxt.pn * tstep : cB;
        for (int t = 0; t < nt; t += 2) {
            const bool last = (t == nt - 2);
            const char* a1 = cA + (size_t)(t + 1) * kstep;
            const char* a2 = last ? nA : cA + (size_t)(t + 2) * kstep; const char* b2 = last ? nB : cB + (size_t)(t + 2) * kstep;
            const char* a3 = a2 + kstep; const char* b3 = b2 + kstep;
            if (last && has_next) S.a_ready(nxt);
            if constexpr (SP2) {
            PG8_LDB(B0, 0, 0); PG8_LDB(B1, 0, 1); PG8_SCHED; PG8_LDA(At, 0, 0); PG8_STAGE(PG8_SA(1, 1), a1 + hstep, voffA);
            PG8_WAIT_V(8); PG8_WAIT_L(0); PG8_BAR; PG8_MMA(0, 0, At, B0); PG8_MMA(0, 1, At, B1); PG8_BAR; PG8_SCHED;
            PG8_LDA(At, 0, 1); PG8_STAGE(PG8_SB(0, 0), b2, voffB); PG8_STAGE(PG8_SB(0, 1), b2 + hstep, voffB); PG8_STAGE(PG8_SA(0, 0), a2, voffA);
            PG8_WAIT_V(8); PG8_WAIT_L(0); PG8_BAR; PG8_MMA(1, 0, At, B0); PG8_MMA(1, 1, At, B1); PG8_BAR; PG8_SCHED;
            PG8_LDB(B0, 1, 0); PG8_LDB(B1, 1, 1); PG8_SCHED; PG8_LDA(At, 1, 0); PG8_STAGE(PG8_SA(0, 1), a2 + hstep, voffA);
            PG8_WAIT_V(8); PG8_WAIT_L(0); PG8_BAR; PG8_MMA(0, 0, At, B0); PG8_MMA(0, 1, At, B1); PG8_BAR; PG8_SCHED;
            PG8_LDA(At, 1, 1); PG8_STAGE(PG8_SB(1, 0), b3, voffB); PG8_STAGE(PG8_SB(1, 1), b3 + hstep, voffB); PG8_STAGE(PG8_SA(1, 0), a3, voffA);
            PG8_WAIT_V(8); PG8_WAIT_L(0); PG8_BAR; PG8_MMA(1, 0, At, B0); PG8_MMA(1, 1, At, B1); PG8_BAR; PG8_SCHED;
            } else {
            PG8_LDB(B0, 0, 0); PG8_SCHED; PG8_LDA(At, 0, 0); PG8_STAGE(PG8_SA(1, 1), a1 + hstep, voffA);
            PG8_WAIT_L(8); PG8_BAR; PG8_WAIT_L(0); PG8_MMA(0, 0, At, B0); PG8_BAR; PG8_SCHED;
            PG8_LDB(B1, 0, 1); PG8_STAGE(PG8_SB(0, 0), b2, voffB);
            PG8_BAR; PG8_WAIT_L(0); PG8_MMA(0, 1, At, B1); PG8_BAR;
            PG8_LDA(At, 0, 1); PG8_STAGE(PG8_SA(0, 0), a2, voffA);
            PG8_BAR; PG8_WAIT_L(0); PG8_MMA(1, 0, At, B0); PG8_BAR; PG8_SCHED;
            PG8_STAGE(PG8_SB(0, 1), b2 + hstep, voffB);
            PG8_WAIT_V(6); PG8_BAR; PG8_MMA(1, 1, At, B1); PG8_BAR;
            PG8_LDB(B0, 1, 0); PG8_SCHED; PG8_LDA(At, 1, 0); PG8_STAGE(PG8_SA(0, 1), a2 + hstep, voffA);
            PG8_WAIT_L(8); PG8_BAR; PG8_WAIT_L(0); PG8_MMA(0, 0, At, B0); PG8_BAR; PG8_SCHED;
            PG8_LDB(B1, 1, 1); PG8_STAGE(PG8_SB(1, 0), b3, voffB);
            PG8_BAR; PG8_WAIT_L(0); PG8_MMA(0, 1, At, B1); PG8_BAR;
            PG8_LDA(At, 1, 1); PG8_STAGE(PG8_SA(1, 0), a3, voffA);
            PG8_BAR; PG8_WAIT_L(0); PG8_MMA(1, 0, At, B0); PG8_BAR; PG8_SCHED;
            PG8_STAGE(PG8_SB(1, 1), b3 + hstep, voffB);
            PG8_WAIT_V(6); PG8_BAR; PG8_MMA(1, 1, At, B1); PG8_BAR;
            }
        }
        if constexpr (ALIGN_EPI) { if (wr == 0) PG8_BAR; }
        if constexpr (!Epi::AFTER_DRAIN) { E(acc, cur, wr, wc, fr, fq); S.done(cur); }
        if (!has_next) break;
#pragma unroll
        for (int a = 0; a < 2; ++a)
#pragma unroll
            for (int b = 0; b < 2; ++b)
#pragma unroll
                for (int m = 0; m < 4; ++m)
#pragma unroll
                    for (int n = 0; n < 2; ++n) acc[a][b][m][n] = (f32x4){0.f, 0.f, 0.f, 0.f};
        cur = nxt; cA = nA; cB = nB; ++ui;
        if constexpr (ALIGN_EPI) { if (wr == 1) PG8_BAR; }
    }
    PG8_WAIT_V(0);
    if constexpr (!ALIGN_EPI) { if (wr == 0) PG8_BAR; }
    PG8_BAR;
    if constexpr (Epi::AFTER_DRAIN) { E.fused(acc, cur, wr, wc, fr, fq, lds, wid, lane); S.done(cur); }
#undef PG8_SA
#undef PG8_SB
#undef PG8_STAGE
#undef PG8_LDA
#undef PG8_LDB
#undef PG8_MMA
#undef PG8_WAIT_V
#undef PG8_WAIT_L
#undef PG8_BAR
#undef PG8_SCHED
}
}

#define LAS __attribute__((address_space(3)))
typedef unsigned short bf16;
typedef unsigned v4u __attribute__((ext_vector_type(4)));
typedef unsigned v2u __attribute__((ext_vector_type(2)));
typedef float f32x4 __attribute__((ext_vector_type(4)));
typedef short bf16x8 __attribute__((ext_vector_type(8)));
typedef short s16x4 __attribute__((ext_vector_type(4)));
#define LDS_WAIT() asm volatile("s_waitcnt lgkmcnt(0)" ::: "memory")

constexpr int BATCH = 2, T = 8192, D = 1024, M = BATCH * T, FF = 2816, DIN = 1976, DINP = 2048, NMOD = 9 * D;
constexpr float ALPHA = 1.18920711500272f;
constexpr float LN_EPS = 1e-5f;
constexpr float QS_NSA = 0.125f * 1.4426950408889634f;
constexpr float QS_MLA = 0.10206207261596575f * 1.4426950408889634f;
constexpr int LDS_BYTES = 147456;
constexpr int NTHREADS = 512;

constexpr size_t MiB = 1u << 20;
constexpr size_t WS_MOD = 0, WS_POSB = 128 * 1024, WS_CS8 = 256 * 1024, WS_CS16 = 57 * MiB;
constexpr size_t WS_WGU1 = 1 * MiB, WS_WD1 = 12 * MiB, WS_WGU2 = 18 * MiB, WS_WD2 = 29 * MiB, WS_WIN = 35 * MiB, WS_WOUT = 39 * MiB, WS_WUQ = 41 * MiB, WS_WUKV = 42 * MiB,
                 WS_W1K = 43 * MiB, WS_W1V = 44 * MiB, WS_KCMP = 45 * MiB, WS_VCMP = 45 * MiB + 512 * 1024, WS_YK = 46 * MiB, WS_YV = 50 * MiB, WS_GATES = 54 * MiB, WS_KR = 56 * MiB,
                 WS_U = 58 * MiB, WS_BIG = 90 * MiB;
constexpr size_t WS_HFF = WS_BIG, WS_H = WS_BIG, WS_QMLA = WS_BIG, WS_KVMLA = WS_BIG + 24 * MiB, WS_QN = WS_BIG + 64 * MiB, WS_KV6 = WS_BIG + 80 * MiB, WS_CQN = WS_BIG + 104 * MiB, WS_CKVN = WS_BIG + 116 * MiB;
constexpr size_t KV6_SEG = (size_t)BATCH * 2 * T * 64;
constexpr size_t WS_END = WS_BIG + 124 * MiB;
static_assert(WS_END <= 256 * MiB, "ws map");

struct Args { const float* in[24]; float* out; unsigned char* ws; double inv8[8]; double inv16[16]; };

__device__ __forceinline__ float wave_sum(float v) {
#pragma unroll
    for (int o = 1; o < 64; o <<= 1) v += __shfl_xor(v, o);
    return v;
}
__device__ __forceinline__ unsigned f2bf(float f) { unsigned u = __builtin_bit_cast(unsigned, f); return (u + 0x7fffu + ((u >> 16) & 1u)) >> 16; }
__device__ __forceinline__ unsigned pk2(float lo, float hi) { return f2bf(lo) | (f2bf(hi) << 16); }
__device__ __forceinline__ float bf2f(unsigned short h) { return __builtin_bit_cast(float, (unsigned)h << 16); }
__device__ __forceinline__ void rope_cs(int pos, double invrev, float& c, float& s) {
    double a = (double)pos * invrev; a -= __builtin_floor(a); const float f = (float)a;
    s = __builtin_amdgcn_sinf(f); c = __builtin_amdgcn_cosf(f);
}

namespace pg8 {
struct EpiSwiglu {
    static constexpr bool PERM = true, AFTER_DRAIN = false;
    bf16_t* O; int ldc;
    __device__ __forceinline__ void operator()(const f32x4 (&acc)[2][2][4][2], const Unit& u, int wr, int wc, int fr, int fq) const {
        const int row0 = u.pm * BM + wr * 64 + fr, col0 = u.pn * 128 + wc * 32 + 8 * fq;
#pragma unroll
        for (int ai = 0; ai < 2; ++ai)
#pragma unroll
            for (int m = 0; m < 4; ++m) {
                bf16_t* rowp = O + (size_t)(row0 + ai * HALF + m * 16) * ldc + col0;
                float h[8];
#pragma unroll
                for (int n = 0; n < 2; ++n)
#pragma unroll
                    for (int e = 0; e < 4; ++e) { const float g = acc[ai][0][m][n][e], up = acc[ai][1][m][n][e]; h[4 * n + e] = g * __builtin_amdgcn_rcpf(1.f + __expf(-g)) * up; }
                u32x4 w; w.x = cvt_pk_bf16(h[0], h[1]); w.y = cvt_pk_bf16(h[2], h[3]); w.z = cvt_pk_bf16(h[4], h[5]); w.w = cvt_pk_bf16(h[6], h[7]);
                *(u32x4*)rowp = w;
            }
    }
};
struct EpiResid {
    static constexpr bool PERM = false, AFTER_DRAIN = false;
    const float* xin; float* out; const float* gate; float coef;
    __device__ __forceinline__ void operator()(const f32x4 (&acc)[2][2][4][2], const Unit& u, int wr, int wc, int fr, int fq) const {
        const int row0 = u.pm * BM + wr * 64 + fr, col0 = u.pn * BM + wc * 32 + 4 * fq;
#pragma unroll
        for (int ai = 0; ai < 2; ++ai)
#pragma unroll
            for (int m = 0; m < 4; ++m) {
                const int row = row0 + ai * HALF + m * 16; const int b = row >> 13;
#pragma unroll
                for (int bj = 0; bj < 2; ++bj)
#pragma unroll
                    for (int n = 0; n < 2; ++n) {
                        const int col = col0 + bj * HALF + n * 16;
                        const f32x4 gv = *(const f32x4*)(gate + (size_t)b * 9216 + col);
                        const f32x4 xv = *(const f32x4*)(xin + (size_t)row * 1024 + col);
                        const f32x4 o = xv * ALPHA + (gv + 1.0f) * coef * acc[ai][bj][m][n];
                        *(f32x4*)(out + (size_t)row * 1024 + col) = o;
                    }
            }
    }
};
struct EpiF32 {
    static constexpr bool PERM = false, AFTER_DRAIN = false;
    float* out; int ldc;
    __device__ __forceinline__ void operator()(const f32x4 (&acc)[2][2][4][2], const Unit& u, int wr, int wc, int fr, int fq) const {
        const int row0 = u.pm * BM + wr * 64 + fr, col0 = u.pn * BM + wc * 32 + 4 * fq;
#pragma unroll
        for (int ai = 0; ai < 2; ++ai)
#pragma unroll
            for (int m = 0; m < 4; ++m)
#pragma unroll
                for (int bj = 0; bj < 2; ++bj)
#pragma unroll
                    for (int n = 0; n < 2; ++n) *(f32x4*)(out + (size_t)(row0 + ai * HALF + m * 16) * ldc + col0 + bj * HALF + n * 16) = acc[ai][bj][m][n];
    }
};
struct EpiQmla {
    static constexpr bool PERM = false, AFTER_DRAIN = false;
    bf16_t* O; const float* cst;
    __device__ __forceinline__ void operator()(const f32x4 (&acc)[2][2][4][2], const Unit& u, int wr, int wc, int fr, int fq) const {
        const int row0 = u.pm * BM + wr * 64 + fr, col0 = u.pn * BM + wc * 32 + 4 * fq;
        if (u.pn < 2) {
#pragma unroll
            for (int ai = 0; ai < 2; ++ai)
#pragma unroll
                for (int m = 0; m < 4; ++m)
#pragma unroll
                    for (int bj = 0; bj < 2; ++bj)
#pragma unroll
                        for (int n = 0; n < 2; ++n) { const f32x4 v = acc[ai][bj][m][n] * QS_MLA; unsigned lo = cvt_pk_bf16(v[0], v[1]), hi = cvt_pk_bf16(v[2], v[3]);
                            unsigned long long w = (unsigned long long)lo | ((unsigned long long)hi << 32);
                            *(unsigned long long*)(O + (size_t)(row0 + ai * HALF + m * 16) * 768 + col0 + bj * HALF + n * 16) = w; }
        } else {
#pragma unroll
            for (int ai = 0; ai < 2; ++ai)
#pragma unroll
                for (int m = 0; m < 4; ++m) {
                    const int row = row0 + ai * HALF + m * 16; const int pos = row & 8191;
                    const f32x4 cs = *(const f32x4*)(cst + (size_t)pos * 32 + 4 * fq), sn = *(const f32x4*)(cst + (size_t)pos * 32 + 16 + 4 * fq);
#pragma unroll
                    for (int bj = 0; bj < 2; ++bj) {
                        const f32x4 x1 = acc[ai][bj][m][0], x2 = acc[ai][bj][m][1];
                        const f32x4 o1 = (x1 * cs - x2 * sn) * QS_MLA, o2 = (x2 * cs + x1 * sn) * QS_MLA;
                        bf16_t* p = O + (size_t)row * 768 + col0 + bj * HALF;
                        *(unsigned long long*)(p) = (unsigned long long)cvt_pk_bf16(o1[0], o1[1]) | ((unsigned long long)cvt_pk_bf16(o1[2], o1[3]) << 32);
                        *(unsigned long long*)(p + 16) = (unsigned long long)cvt_pk_bf16(o2[0], o2[1]) | ((unsigned long long)cvt_pk_bf16(o2[2], o2[3]) << 32);
                    }
                }
        }
    }
};
}

namespace att {
constexpr int OFF_K = 0, OFF_V = 13312, OFF_SEL = 22528, OFF_IMP = 23552, OFF_OC = OFF_IMP + 64 * 132 * 4, OFF_END = OFF_OC + 8 * 512 * 16;
static_assert(OFF_END <= 147456 && OFF_OC % 16 == 0, "attention LDS map");
constexpr int VSTR = 72, ISTR = 132;
enum { CAUSAL = 0, WINDOW = 1, CMP = 2, SEL = 3 };
constexpr float NEG = -1e30f;

template <int DQK> struct Stage { v4u k0, k1, v; };

template <int DQK> __device__ __forceinline__ void stage_load(Stage<DQK>& s, const bf16* K0, int p0, const bf16* K1, int p1, const bf16* V, int pv, int tile, bool withV, int tid) {
    { const int key = tid >> 3, c = tid & 7; s.k0 = *(const v4u*)(K0 + (size_t)(64 * tile + key) * p0 + 8 * c); }
    if (DQK == 96) { if (tid < 256) { const int key = tid >> 2, c = tid & 3; s.k1 = *(const v4u*)(K1 + (size_t)(64 * tile + key) * p1 + 8 * c); } }
    if (withV) { const int w = tid >> 6, ky = tid & 63; s.v = *(const v4u*)(V + (size_t)(64 * tile + ky) * pv + 8 * w); }
}
template <int DQK> __device__ __forceinline__ void stage_store(const Stage<DQK>& s, LAS unsigned char* lds, bool withV, int tid) {
    constexpr int KSTR = DQK + 8;
    { const int key = tid >> 3, c = tid & 7; *(LAS v4u*)(lds + OFF_K + (key * KSTR + 8 * c) * 2) = s.k0; }
    if (DQK == 96) { if (tid < 256) { const int key = tid >> 2, c = tid & 3; *(LAS v4u*)(lds + OFF_K + (key * KSTR + 64 + 8 * c) * 2) = s.k1; } }
    if (withV) { const int w = tid >> 6, ky = tid & 63; LAS unsigned short* vt = (LAS unsigned short*)(lds + OFF_V);
#pragma unroll
        for (int e = 0; e < 8; ++e) vt[(8 * w + e) * VSTR + ky] = (unsigned short)((s.v[e >> 1] >> (16 * (e & 1))) & 0xffffu); }
}

template <int DQK> __device__ __forceinline__ void qk_tile(LAS unsigned char* lds, const bf16x8 (&qf)[DQK / 32], f32x4 (&s)[4], int fr, int fq) {
    constexpr int KSTR = DQK + 8, NKS = DQK / 32;
#pragma unroll
    for (int ss = 0; ss < 4; ++ss) {
        s[ss] = (f32x4){0.f, 0.f, 0.f, 0.f};
#pragma unroll
        for (int ks = 0; ks < NKS; ++ks) {
            const bf16x8 kf = *(const LAS bf16x8*)(lds + OFF_K + ((16 * ss + fr) * KSTR + 32 * ks + 8 * fq) * 2);
            s[ss] = __builtin_amdgcn_mfma_f32_16x16x32_bf16(kf, qf[ks], s[ss], 0, 0, 0);
        }
    }
}
template <int MODE> __device__ __forceinline__ bool key_ok(int kpos, int tpos, bool rowsel) {
    if (MODE == CAUSAL) return kpos <= tpos;
    if (MODE == WINDOW) return kpos <= tpos && kpos + 512 > tpos;
    if (MODE == CMP) return 16 * kpos + 31 <= tpos;
    return rowsel && kpos <= tpos;
}
template <int DQK, int MODE> __device__ __forceinline__ void qt_tile(LAS unsigned char* lds, const bf16x8 (&qf)[DQK / 32], int kbase, int tpos, bool rowsel, float& m, float& l, f32x4 (&o)[4], int fr, int fq) {
    f32x4 s[4];
    __builtin_amdgcn_sched_barrier(0);
    qk_tile<DQK>(lds, qf, s, fr, fq);
    __builtin_amdgcn_sched_barrier(0);
    float mx = NEG;
#pragma unroll
    for (int ss = 0; ss < 4; ++ss)
#pragma unroll
        for (int i = 0; i < 4; ++i) { const bool ok = key_ok<MODE>(kbase + 16 * ss + 4 * fq + i, tpos, rowsel); const float v = ok ? s[ss][i] : NEG; s[ss][i] = v; mx = fmaxf(mx, v); }
    mx = fmaxf(mx, __shfl_xor(mx, 16)); mx = fmaxf(mx, __shfl_xor(mx, 32));
    const float mnew = fmaxf(m, mx);
    const float alpha = __builtin_amdgcn_exp2f(m - mnew);
    float rs = 0.f;
#pragma unroll
    for (int ss = 0; ss < 4; ++ss)
#pragma unroll
        for (int i = 0; i < 4; ++i) { const float v = s[ss][i]; const float p = (v > -1e29f) ? __builtin_amdgcn_exp2f(v - mnew) : 0.f; s[ss][i] = p; rs += p; }
    l = l * alpha + rs; m = mnew;
#pragma unroll
    for (int dt = 0; dt < 4; ++dt) o[dt] = o[dt] * alpha;
    bf16x8 pb[2];
#pragma unroll
    for (int j = 0; j < 2; ++j) {
        const unsigned a0 = pk2(s[2 * j][0], s[2 * j][1]), a1 = pk2(s[2 * j][2], s[2 * j][3]), a2 = pk2(s[2 * j + 1][0], s[2 * j + 1][1]), a3 = pk2(s[2 * j + 1][2], s[2 * j + 1][3]);
        const v4u w = (v4u){a0, a1, a2, a3}; pb[j] = __builtin_bit_cast(bf16x8, w);
    }
    __builtin_amdgcn_sched_barrier(0);
#pragma unroll
    for (int dt = 0; dt < 4; ++dt)
#pragma unroll
        for (int j = 0; j < 2; ++j) {
            const LAS unsigned char* vp = lds + OFF_V + ((16 * dt + fr) * VSTR + 32 * j + 4 * fq) * 2;
            const v2u lo = *(const LAS v2u*)vp, hi = *(const LAS v2u*)(vp + 32);
            const v4u w = (v4u){lo.x, lo.y, hi.x, hi.y};
            o[dt] = __builtin_amdgcn_mfma_f32_16x16x32_bf16(__builtin_bit_cast(bf16x8, w), pb[j], o[dt], 0, 0, 0);
        }
    __builtin_amdgcn_sched_barrier(0);
}

template <int DQK, int MODE> __device__ __forceinline__ void attn_pass(LAS unsigned char* lds, const bf16* K0, int p0, const bf16* K1, int p1, const bf16* V, int pv, int tlo, int thi,
        const bf16x8 (&qf)[2][DQK / 32], const int (&tpos)[2], const int (&tok)[2], int wave_tmax, f32x4 (&o)[2][4], float (&mfin)[2], float (&linv)[2], int tid, int fr, int fq) {
    asm volatile("" : "+v"(tid)); asm volatile("" : "+s"(K0), "+s"(V)); if (DQK == 96) asm volatile("" : "+s"(K1));
    fr = tid & 15; fq = (tid & 63) >> 4;
    float m[2] = {NEG, NEG}, l[2] = {0.f, 0.f};
#pragma unroll
    for (int i = 0; i < 2; ++i)
#pragma unroll
        for (int dt = 0; dt < 4; ++dt) o[i][dt] = (f32x4){0.f, 0.f, 0.f, 0.f};
    Stage<DQK> st;
    stage_load<DQK>(st, K0, p0, K1, p1, V, pv, tlo, true, tid);
    for (int t = tlo; t <= thi; ++t) {
        __syncthreads();
        stage_store<DQK>(st, lds, true, tid);
        __syncthreads();
        if (t < thi) stage_load<DQK>(st, K0, p0, K1, p1, V, pv, t + 1, true, tid);
        const int kbase = 64 * t;
        const bool skip = (MODE == CMP) ? (16 * kbase + 31 > wave_tmax) : (kbase > wave_tmax);
        if (!skip) {
#pragma unroll
            for (int i = 0; i < 2; ++i) {
                bool rowsel = true;
                if (MODE == SEL) { const unsigned w = ((const LAS unsigned*)(lds + OFF_SEL))[tok[i] * 4 + (t >> 5)]; rowsel = ((w >> (t & 31)) & 1u) != 0u; if (!__any(rowsel ? 1 : 0)) continue; }
                qt_tile<DQK, MODE>(lds, qf[i], kbase, tpos[i], rowsel, m[i], l[i], o[i], fr, fq);
            }
        }
    }
#pragma unroll
    for (int i = 0; i < 2; ++i) {
        float lt = l[i]; lt += __shfl_xor(lt, 16); lt += __shfl_xor(lt, 32);
        const float iv = lt > 0.f ? 1.0f / lt : 0.f;
        mfin[i] = m[i]; linv[i] = iv;
#pragma unroll
        for (int dt = 0; dt < 4; ++dt) o[i][dt] = o[i][dt] * iv;
    }
}

struct NsaPtrs { const bf16 *QN, *KV6, *KCMP, *VCMP; const float* GATES; bf16* OCAT; };

__device__ __forceinline__ void nsa_load_q(const bf16* QN, int b, int g, int tid, int t0, bf16x8 (&qf)[2][2]) {
    asm volatile("" : "+v"(tid)); asm volatile("" : "+s"(QN));
    const int wave = tid >> 6, fr = tid & 15, fq = (tid & 63) >> 4, hh = fr >> 2;
#pragma unroll
    for (int i = 0; i < 2; ++i) {
        const size_t mrow = (size_t)b * T + t0 + 8 * wave + 4 * i + (fr & 3);
        const bf16* qrow = QN + mrow * 512 + (g * 4 + hh) * 64;
#pragma unroll
        for (int ks = 0; ks < 2; ++ks) qf[i][ks] = *(const bf16x8*)(qrow + 32 * ks + 8 * fq);
    }
}
__device__ __forceinline__ void nsa_item(LAS unsigned char* lds, const NsaPtrs& P, int b, int g, int qb, int tid) {
    const int wave = tid >> 6, lane = tid & 63, fr = lane & 15, fq = lane >> 4, hh = fr >> 2;
    const int t0 = 64 * qb; const size_t bg = (size_t)(b * 2 + g);
    int tpos[2], tok[2];
#pragma unroll
    for (int i = 0; i < 2; ++i) { tok[i] = 8 * wave + 4 * i + (fr & 3); tpos[i] = t0 + tok[i]; }
    const int wave_tmax = t0 + 8 * wave + 7;
    LAS float* imp = (LAS float*)(lds + OFF_IMP);
    LAS f32x4* ocl = (LAS f32x4*)(lds + OFF_OC);
    for (int idx = tid; idx < 64 * ISTR; idx += NTHREADS) imp[idx] = 0.f;
    bf16x8 qf[2][2]; f32x4 o[2][4]; float mf[2], li[2];
    const bf16* Kc = P.KCMP + bg * 512 * 64; const bf16* Vc = P.VCMP + bg * 512 * 64;
    const int thi_c = ((t0 + 63 - 31) >> 4) >> 6;
    nsa_load_q(P.QN, b, g, tid, t0, qf);
    attn_pass<64, CMP>(lds, Kc, 64, nullptr, 0, Vc, 64, 0, thi_c, qf, tpos, tok, wave_tmax, o, mf, li, tid, fr, fq);
#pragma unroll
    for (int i = 0; i < 2; ++i) { const float gc = P.GATES[((size_t)b * T + tpos[i]) * 24 + g * 12 + hh * 3 + 0];
#pragma unroll
        for (int dt = 0; dt < 4; ++dt) ocl[(i * 4 + dt) * NTHREADS + tid] = o[i][dt] * gc; }
#ifndef NSA_NO_IMP
    int tid_i = tid; asm volatile("" : "+v"(tid_i)); const int fr_i = tid_i & 15, fq_i = (tid_i & 63) >> 4; asm volatile("" : "+s"(Kc));
    for (int t = 0; t <= thi_c; ++t) {
        __syncthreads();
        { const int key = tid_i >> 3, c = tid_i & 7; *(LAS v4u*)(lds + OFF_K + (key * 72 + 8 * c) * 2) = *(const v4u*)(Kc + (size_t)(64 * t + key) * 64 + 8 * c); }
        __syncthreads();
        if (16 * (64 * t) + 31 > wave_tmax) continue;
#pragma unroll
        for (int i = 0; i < 2; ++i) {
            f32x4 s[4];
            qk_tile<64>(lds, qf[i], s, fr_i, fq_i);
#pragma unroll
            for (int ss = 0; ss < 4; ++ss) {
                float a = 0.f, b3 = 0.f;
#pragma unroll
                for (int e = 0; e < 4; ++e) { const int n = 64 * t + 16 * ss + 4 * fq_i + e; const float p = (16 * n + 31 <= tpos[i]) ? __builtin_amdgcn_exp2f(s[ss][e] - mf[i]) * li[i] : 0.f; a += p; if (e == 3) b3 = p; }
                a += __shfl_xor(a, 4); a += __shfl_xor(a, 8); b3 += __shfl_xor(b3, 4); b3 += __shfl_xor(b3, 8);
                if (fr_i < 4) { const int jp = 16 * t + 4 * ss + fq_i;
                    __hip_atomic_fetch_add(imp + tok[i] * ISTR + jp, a, __ATOMIC_RELAXED, __HIP_MEMORY_SCOPE_WORKGROUP);
                    __hip_atomic_fetch_add(imp + tok[i] * ISTR + jp + 1, b3, __ATOMIC_RELAXED, __HIP_MEMORY_SCOPE_WORKGROUP); }
            }
        }
    }
#endif
    __syncthreads();
#ifndef NSA_NO_TOPK
    {
        int tid_k = tid; asm volatile("" : "+v"(tid_k)); const int tk = tid_k >> 3, part = tid_k & 7;
        float v[16]; int cnt[16];
#pragma unroll
        for (int jj = 0; jj < 16; ++jj) { const int j = part * 16 + jj; const bool causal = j <= qb, forced = (j == 0) || (j == qb) || (j == qb - 1);
            const float val = !causal ? -1.0f : (forced ? 1e9f : imp[tk * ISTR + j]); v[jj] = val; cnt[jj] = 0; }
        __syncthreads();
#pragma unroll
        for (int jj = 0; jj < 16; ++jj) imp[tk * ISTR + part * 16 + jj] = v[jj];
        __syncthreads();
        for (int k = 0; k <= qb; ++k) { const float vk = imp[tk * ISTR + k];
#pragma unroll
            for (int jj = 0; jj < 16; ++jj) { const int j = part * 16 + jj; cnt[jj] += ((vk > v[jj]) || (vk == v[jj] && k < j)) ? 1 : 0; } }
        unsigned bits = 0u;
#pragma unroll
        for (int jj = 0; jj < 16; ++jj) { const int j = part * 16 + jj; if (j <= qb && cnt[jj] < 16) bits |= (1u << jj); }
        ((LAS unsigned short*)(lds + OFF_SEL))[tk * 8 + part] = (unsigned short)bits;
    }
#endif
    __syncthreads();
#ifndef NSA_NO_SEL
    nsa_load_q(P.QN, b, g, tid, t0, qf);
    attn_pass<64, SEL>(lds, P.KV6 + 2 * KV6_SEG + bg * T * 64, 64, nullptr, 0, P.KV6 + 3 * KV6_SEG + bg * T * 64, 64, 0, qb, qf, tpos, tok, wave_tmax, o, mf, li, tid, fr, fq);
#pragma unroll
    for (int i = 0; i < 2; ++i) { const float gs = P.GATES[((size_t)b * T + tpos[i]) * 24 + g * 12 + hh * 3 + 1];
#pragma unroll
        for (int dt = 0; dt < 4; ++dt) ocl[(i * 4 + dt) * NTHREADS + tid] += o[i][dt] * gs; }
#endif
    nsa_load_q(P.QN, b, g, tid, t0, qf);
    attn_pass<64, WINDOW>(lds, P.KV6 + 4 * KV6_SEG + bg * T * 64, 64, nullptr, 0, P.KV6 + 5 * KV6_SEG + bg * T * 64, 64, (qb >= 8 ? qb - 8 : 0), qb, qf, tpos, tok, wave_tmax, o, mf, li, tid, fr, fq);
#pragma unroll
    for (int i = 0; i < 2; ++i) {
        const float gw = P.GATES[((size_t)b * T + tpos[i]) * 24 + g * 12 + hh * 3 + 2];
        bf16* orow = P.OCAT + ((size_t)b * T + tpos[i]) * 1024 + (g * 4 + hh) * 64 + 4 * fq;
#pragma unroll
        for (int dt = 0; dt < 4; ++dt) { const f32x4 r = ocl[(i * 4 + dt) * NTHREADS + tid] + o[i][dt] * gw;
            *(unsigned long long*)(orow + 16 * dt) = (unsigned long long)pk2(r[0], r[1]) | ((unsigned long long)pk2(r[2], r[3]) << 32); }
    }
}

struct MlaPtrs { const bf16 *QMLA, *KVMLA, *KR; bf16* OCAT; };
__device__ __forceinline__ void mla_item(LAS unsigned char* lds, const MlaPtrs& P, int b, int h, int qb, int tid) {
    const int wave = tid >> 6, lane = tid & 63, fr = lane & 15, fq = lane >> 4;
    const int t0 = 256 * qb;
    int tpos[2], tok[2]; bf16x8 qf[2][3];
#pragma unroll
    for (int i = 0; i < 2; ++i) {
        tok[i] = 0; tpos[i] = t0 + 32 * wave + 16 * i + fr;
        const bf16* qrow = P.QMLA + ((size_t)b * T + tpos[i]) * 768;
        qf[i][0] = *(const bf16x8*)(qrow + h * 64 + 8 * fq); qf[i][1] = *(const bf16x8*)(qrow + h * 64 + 32 + 8 * fq); qf[i][2] = *(const bf16x8*)(qrow + 512 + h * 32 + 8 * fq);
    }
    const int wave_tmax = t0 + 32 * wave + 31;
    f32x4 o[2][4]; float mf[2], li[2];
    const bf16* kv = P.KVMLA + (size_t)b * T * 1024;
    attn_pass<96, CAUSAL>(lds, kv + h * 64, 1024, P.KR + (size_t)b * T * 32, 32, kv + 512 + h * 64, 1024, 0, 4 * qb + 3, qf, tpos, tok, wave_tmax, o, mf, li, tid, fr, fq);
#pragma unroll
    for (int i = 0; i < 2; ++i) {
        bf16* orow = P.OCAT + ((size_t)b * T + tpos[i]) * 1024 + 512 + h * 64 + 4 * fq;
#pragma unroll
        for (int dt = 0; dt < 4; ++dt) { const f32x4 r = o[i][dt];
            *(unsigned long long*)(orow + 16 * dt) = (unsigned long long)pk2(r[0], r[1]) | ((unsigned long long)pk2(r[2], r[3]) << 32); }
    }
}
}

__device__ __forceinline__ void tr_item(const float* W, int N, int k0, int n0, bf16* WT, int Kd, int drow0, int dk0, LAS float* scr, int lane) {
#pragma unroll 8
    for (int i = 0; i < 32; ++i) { const int kk = 2 * i + (lane >> 5); const int n = n0 + (lane & 31); scr[kk * 33 + (lane & 31)] = (n < N) ? W[(size_t)(k0 + kk) * N + n] : 0.f; }
    LDS_WAIT();
    const int c = lane & 7;
#pragma unroll
    for (int j = 0; j < 4; ++j) { const int n = (lane >> 3) + 8 * j; const LAS float* s = scr + (8 * c) * 33 + n;
        v4u o; o.x = pk2(s[0 * 33], s[1 * 33]); o.y = pk2(s[2 * 33], s[3 * 33]); o.z = pk2(s[4 * 33], s[5 * 33]); o.w = pk2(s[6 * 33], s[7 * 33]);
        *(v4u*)(WT + (size_t)(drow0 + n) * Kd + dk0 + 8 * c) = o; }
    LDS_WAIT();
}

template <bool DO_LN, bool DO_U> __device__ __forceinline__ void row_pass(const float* xin, float* xout, const float* lng, const float* lnb, const float* mod, int sh_off, int sc_off, bf16* U, int gw, int NGW, int lane) {
    for (int m = gw; m < M; m += NGW) {
        const int b = m >> 13;
        const f32x4* xr = (const f32x4*)(xin + (size_t)m * D) + lane;
        f32x4 v[4];
#pragma unroll
        for (int j = 0; j < 4; ++j) v[j] = xr[64 * j];
        if (DO_LN) {
            float s = 0.f;
#pragma unroll
            for (int j = 0; j < 4; ++j) s += (v[j].x + v[j].y) + (v[j].z + v[j].w);
            const float mean = wave_sum(s) * (1.f / D); float s2 = 0.f;
#pragma unroll
            for (int j = 0; j < 4; ++j) { v[j] = v[j] - mean; s2 += (v[j].x * v[j].x + v[j].y * v[j].y) + (v[j].z * v[j].z + v[j].w * v[j].w); }
            const float rstd = 1.f / sqrtf(wave_sum(s2) * (1.f / D) + LN_EPS);
            f32x4* xo = (f32x4*)(xout + (size_t)m * D) + lane;
#pragma unroll
            for (int j = 0; j < 4; ++j) { const f32x4 gg = *((const f32x4*)lng + lane + 64 * j), bb = *((const f32x4*)lnb + lane + 64 * j); v[j] = v[j] * rstd * gg + bb; xo[64 * j] = v[j]; }
        }
        if (DO_U) {
            const f32x4* shp = (const f32x4*)(mod + (size_t)b * NMOD + sh_off) + lane; const f32x4* scp = (const f32x4*)(mod + (size_t)b * NMOD + sc_off) + lane;
            unsigned long long* o8 = (unsigned long long*)(U + (size_t)m * D) + lane;
#pragma unroll
            for (int j = 0; j < 4; ++j) { const f32x4 u = v[j] * (scp[64 * j] + 1.0f) + shp[64 * j];
                o8[64 * j] = (unsigned long long)pk2(u.x, u.y) | ((unsigned long long)pk2(u.z, u.w) << 32); }
        }
    }
}

__global__ void __launch_bounds__(NTHREADS, 2) mega_fwd(Args a_unused) {
    extern __shared__ __attribute__((aligned(16))) unsigned char lds_raw[];
    cg::grid_group grid = cg::this_grid();
    (void)a_unused;
#define PH_BEGIN { const Args* ap = (const Args*)__builtin_amdgcn_kernarg_segment_ptr(); asm volatile("" : "+s"(ap)); unsigned char* ws; { const unsigned long long w_ = (unsigned long long)ap->ws; const unsigned lo_ = __builtin_amdgcn_readfirstlane((unsigned)w_), hi_ = __builtin_amdgcn_readfirstlane((unsigned)(w_ >> 32)); ws = (unsigned char*)(((unsigned long long)hi_ << 32) | lo_); } asm volatile("" : "+s"(ws)); \
    LAS unsigned char* lds = (LAS unsigned char*)lds_raw; const int tid = threadIdx.x, lane = tid & 63, wave = __builtin_amdgcn_readfirstlane(tid >> 6); \
    const int G = gridDim.x, bx = blockIdx.x, gw = bx * 8 + wave, NGW = G * 8; (void)lane; (void)gw; (void)NGW; (void)lds;
#define PH_END } grid.sync();
#define mod ((float*)(ws + WS_MOD))
#define posb ((float*)(ws + WS_POSB))
#define CS8 ((float*)(ws + WS_CS8))
#define CS16 ((float*)(ws + WS_CS16))
#define Wgu1 ((bf16*)(ws + WS_WGU1))
#define Wd1 ((bf16*)(ws + WS_WD1))
#define Wgu2 ((bf16*)(ws + WS_WGU2))
#define Wd2 ((bf16*)(ws + WS_WD2))
#define Win ((bf16*)(ws + WS_WIN))
#define Wout ((bf16*)(ws + WS_WOUT))
#define Wuq ((bf16*)(ws + WS_WUQ))
#define Wukv ((bf16*)(ws + WS_WUKV))
#define W1k ((bf16*)(ws + WS_W1K))
#define W1v ((bf16*)(ws + WS_W1V))
#define KCMP ((bf16*)(ws + WS_KCMP))
#define VCMP ((bf16*)(ws + WS_VCMP))
#define YK ((float*)(ws + WS_YK))
#define YV ((float*)(ws + WS_YV))
#define GATES ((float*)(ws + WS_GATES))
#define KR ((bf16*)(ws + WS_KR))
#define U ((bf16*)(ws + WS_U))
#define HFF ((bf16*)(ws + WS_HFF))
#define H ((bf16*)(ws + WS_H))
#define QMLA ((bf16*)(ws + WS_QMLA))
#define KVMLA ((bf16*)(ws + WS_KVMLA))
#define QN ((bf16*)(ws + WS_QN))
#define KV6 ((bf16*)(ws + WS_KV6))
#define CQN ((bf16*)(ws + WS_CQN))
#define CKVN ((bf16*)(ws + WS_CKVN))
#define XIN (ap->in[0])
#define XOUT (ap->out)

    PH_BEGIN
    {
        LAS float* sc = (LAS float*)(lds + 131072);
        for (int i = tid; i < 2 * D; i += NTHREADS) { const float cv = ap->in[1][i]; sc[i] = cv / (1.f + expf(-cv)); }
        __syncthreads();
        LAS float* red = (LAS float*)lds;
        for (int cb = bx; cb < 256; cb += G) {
            const int col = tid % 36, kc = tid / 36, j = 36 * cb + col;
            if (kc < 14) {
                float a0 = 0.f, a1 = 0.f; const int k1 = (kc * 74 + 74 < D) ? kc * 74 + 74 : D;
                for (int k = kc * 74; k < k1; ++k) { const float w = ap->in[2][(size_t)k * NMOD + j]; a0 += sc[k] * w; a1 += sc[D + k] * w; }
                red[(kc * 36 + col) * 2] = a0; red[(kc * 36 + col) * 2 + 1] = a1;
            }
            __syncthreads();
            if (tid < 72) { const int c2 = tid >> 1, bb = tid & 1; float s = ap->in[3][36 * cb + c2];
                for (int q = 0; q < 14; ++q) s += red[(q * 36 + c2) * 2 + bb];
                mod[(size_t)bb * NMOD + 36 * cb + c2] = s; }
            __syncthreads();
        }
        for (int o = gw; o < 512; o += NGW) {
            const int which = o >> 8, j = o & 255; const float* pe = ap->in[which ? 13 : 10]; const float* w1 = ap->in[which ? 14 : 11];
            float s = 0.f;
            for (int k = lane; k < 2048; k += 64) s += pe[k] * w1[(size_t)k * 256 + j];
            s = wave_sum(s);
            if (lane == 0) posb[which * 256 + j] = s;
        }
        for (int e = bx * NTHREADS + tid; e < 8192 * 24; e += G * NTHREADS) {
            const int pos = e / 24, i = e % 24; double iv = 0.0;
#pragma unroll
            for (int q = 0; q < 8; ++q) if (i == q) iv = ap->inv8[q];
#pragma unroll
            for (int q = 0; q < 16; ++q) if (i == 8 + q) iv = ap->inv16[q];
            float c_, s_; rope_cs(pos, iv, c_, s_);
            if (i < 8) { CS8[pos * 16 + i] = c_; CS8[pos * 16 + 8 + i] = s_; } else { CS16[pos * 32 + (i - 8)] = c_; CS16[pos * 32 + 16 + (i - 8)] = s_; }
        }
        __syncthreads();
        LAS float* scr = (LAS float*)(lds + wave * 16384);
        constexpr int I_GU = (D / 64) * (FF / 32), I_WD = (FF / 64) * (D / 32), I_IN = (D / 64) * (DINP / 32), I_W1 = (2048 / 64) * (256 / 32), I_UQ = (384 / 64) * (768 / 32),
                      I_UKV = (256 / 64) * (1024 / 32), I_OUT = (D / 64) * (D / 32);
        constexpr int NITEMS = 4 * I_GU + 2 * I_WD + I_IN + 2 * I_W1 + I_UQ + I_UKV + I_OUT;
        for (int it = gw; it < NITEMS; it += NGW) {
            int r = it;
#define TR_TRY(CNT, NBLK, ...) if (r < (CNT)) { const int k0 = 64 * (r / (NBLK)), n0 = 32 * (r % (NBLK)); (void)k0; (void)n0; __VA_ARGS__; continue; } r -= (CNT);
            TR_TRY(I_GU, FF / 32, tr_item(ap->in[6], FF, k0, n0, Wgu1, D, (n0 / 128) * 256 + (n0 % 128), k0, scr, lane))
            TR_TRY(I_GU, FF / 32, tr_item(ap->in[7], FF, k0, n0, Wgu1, D, (n0 / 128) * 256 + 128 + (n0 % 128), k0, scr, lane))
            TR_TRY(I_WD, D / 32, tr_item(ap->in[8], D, k0, n0, Wd1, FF, n0, k0, scr, lane))
            TR_TRY(I_GU, FF / 32, tr_item(ap->in[21], FF, k0, n0, Wgu2, D, (n0 / 128) * 256 + (n0 % 128), k0, scr, lane))
            TR_TRY(I_GU, FF / 32, tr_item(ap->in[22], FF, k0, n0, Wgu2, D, (n0 / 128) * 256 + 128 + (n0 % 128), k0, scr, lane))
            TR_TRY(I_WD, D / 32, tr_item(ap->in[23], D, k0, n0, Wd2, FF, n0, k0, scr, lane))
            TR_TRY(I_IN, DINP / 32, tr_item(ap->in[9], DIN, k0, n0, Win, D, n0, k0, scr, lane))
            TR_TRY(I_W1, 256 / 32, tr_item(ap->in[11], 256, k0, n0, W1k, 1024, (k0 >= 1024 ? 256 : 0) + n0, k0 & 1023, scr, lane))
            TR_TRY(I_W1, 256 / 32, tr_item(ap->in[14], 256, k0, n0, W1v, 1024, (k0 >= 1024 ? 256 : 0) + n0, k0 & 1023, scr, lane))
            TR_TRY(I_UQ, 768 / 32, { const int hq = n0 / 96, jq = (n0 % 96) / 32; tr_item(ap->in[18], 768, k0, n0, Wuq, 384, jq < 2 ? hq * 64 + 32 * jq : 512 + hq * 32, k0, scr, lane); })
            TR_TRY(I_UKV, 1024 / 32, { const int hk = n0 / 128, ek = n0 % 128; tr_item(ap->in[19], 1024, k0, n0, Wukv, 256, ek < 64 ? hk * 64 + ek : 512 + hk * 64 + (ek - 64), k0, scr, lane); })
            TR_TRY(I_OUT, D / 32, tr_item(ap->in[20], D, k0, n0, Wout, D, n0, k0, scr, lane))
#undef TR_TRY
        }
    }
    PH_END

    PH_BEGIN
    row_pass<false, true>(XIN, nullptr, nullptr, nullptr, mod, 0 * D, 1 * D, U, gw, NGW, lane);
    PH_END

    PH_BEGIN
#if !defined(ONLY_G) || ONLY_G == 1
    { int Kq = D; asm volatile("" : "+s"(Kq)); pg8::Gemm g{U, Wgu1, M, 2 * FF, Kq}; pg8::StaticOrder S; S.init(M, 2 * FF, G, bx); pg8::EpiSwiglu E{HFF, FF};
      pg8::gemm_phase<pg8::EpiSwiglu, pg8::StaticOrder, true, true>(lds, g, S, E); }
#endif
    PH_END
    PH_BEGIN
#if !defined(ONLY_G) || ONLY_G == 2
    { int Kq = FF; asm volatile("" : "+s"(Kq)); pg8::Gemm g{HFF, Wd1, M, D, Kq}; pg8::StaticOrder S; S.init(M, D, G, bx); pg8::EpiResid E{XIN, XOUT, mod + 2 * D, 0.5f};
      pg8::gemm_phase<pg8::EpiResid, pg8::StaticOrder, true, true>(lds, g, S, E); }
#endif
    PH_END
    PH_BEGIN
    row_pass<true, true>(XOUT, XOUT, ap->in[4] + 0 * D, ap->in[5] + 0 * D, mod, 3 * D, 4 * D, U, gw, NGW, lane);
    PH_END
    PH_BEGIN
#if !defined(ONLY_G) || ONLY_G == 3
    { int Kq = D; asm volatile("" : "+s"(Kq)); pg8::Gemm g{U, Win, M, DINP, Kq}; pg8::StaticOrder S; S.init(M, DINP, G, bx); pg8::EpiBf16<0> E{H, DINP, nullptr, 0, 0, 1.f};
      pg8::gemm_phase<pg8::EpiBf16<0>, pg8::StaticOrder, true, true>(lds, g, S, E); }
#endif
    PH_END
    PH_BEGIN
    {
        LAS v4u* rb = (LAS v4u*)(lds + wave * 4096); LAS unsigned short* hb = (LAS unsigned short*)rb;
        for (int m = gw; m < M; m += NGW) {
            const int b = m >> 13, t = m & 8191;
            const v4u* hr = (const v4u*)(H + (size_t)m * DINP);
#pragma unroll
            for (int j = 0; j < 4; ++j) rb[lane + 64 * j] = hr[lane + 64 * j];
            LDS_WAIT();
            {
                const int base = 8 * lane, d0 = 8 * (lane & 7); float v[8];
#pragma unroll
                for (int e = 0; e < 8; ++e) v[e] = bf2f(hb[base + e]);
                if (d0 < 16) {
#pragma unroll
                    for (int e = 0; e < 8; ++e) { const float c_ = CS8[t * 16 + e], s_ = CS8[t * 16 + 8 + e]; const float pr = bf2f(hb[base + e + (d0 == 0 ? 8 : -8)]); v[e] = (d0 == 0) ? v[e] * c_ - pr * s_ : v[e] * c_ + pr * s_; }
                }
                v4u o; o.x = pk2(v[0] * QS_NSA, v[1] * QS_NSA); o.y = pk2(v[2] * QS_NSA, v[3] * QS_NSA); o.z = pk2(v[4] * QS_NSA, v[5] * QS_NSA); o.w = pk2(v[6] * QS_NSA, v[7] * QS_NSA);
                *(v4u*)(QN + (size_t)m * 512 + base) = o;
            }
#pragma unroll
            for (int it = 0; it < 2; ++it) {
                const int ch = lane + 64 * it;
                if (ch < 96) {
                    const int seg = ch >> 4, w = ch & 15, g = w >> 3, d0 = 8 * (w & 7), base = 512 + 128 * seg + 64 * g + d0; float v[8];
#pragma unroll
                    for (int e = 0; e < 8; ++e) v[e] = bf2f(hb[base + e]);
                    if ((seg & 1) == 0 && d0 < 16) {
#pragma unroll
                        for (int e = 0; e < 8; ++e) { const float c_ = CS8[t * 16 + e], s_ = CS8[t * 16 + 8 + e]; const float pr = bf2f(hb[base + e + (d0 == 0 ? 8 : -8)]); v[e] = (d0 == 0) ? v[e] * c_ - pr * s_ : v[e] * c_ + pr * s_; }
                    }
                    v4u o; o.x = pk2(v[0], v[1]); o.y = pk2(v[2], v[3]); o.z = pk2(v[4], v[5]); o.w = pk2(v[6], v[7]);
                    *(v4u*)(KV6 + (size_t)seg * KV6_SEG + ((size_t)(b * 2 + g) * T + t) * 64 + d0) = o;
                }
            }
            if (lane < 24) GATES[(size_t)m * 24 + lane] = 1.f / (1.f + expf(-bf2f(hb[1280 + lane])));
            {
                float xv[6]; float ss = 0.f;
#pragma unroll
                for (int j = 0; j < 3; ++j) { xv[2 * j] = bf2f(hb[1304 + 2 * lane + 128 * j]); xv[2 * j + 1] = bf2f(hb[1304 + 2 * lane + 128 * j + 1]); ss += xv[2 * j] * xv[2 * j] + xv[2 * j + 1] * xv[2 * j + 1]; }
                const float r = 1.f / sqrtf(wave_sum(ss) * (1.f / 384.f) + LN_EPS);
#pragma unroll
                for (int j = 0; j < 3; ++j) { const int i = 2 * lane + 128 * j; *(unsigned*)(CQN + (size_t)m * 384 + i) = pk2(xv[2 * j] * r * ap->in[16][i], xv[2 * j + 1] * r * ap->in[16][i + 1]); }
            }
            {
                float xv[4]; float ss = 0.f;
#pragma unroll
                for (int j = 0; j < 2; ++j) { xv[2 * j] = bf2f(hb[1688 + 2 * lane + 128 * j]); xv[2 * j + 1] = bf2f(hb[1688 + 2 * lane + 128 * j + 1]); ss += xv[2 * j] * xv[2 * j] + xv[2 * j + 1] * xv[2 * j + 1]; }
                const float r = 1.f / sqrtf(wave_sum(ss) * (1.f / 256.f) + LN_EPS);
#pragma unroll
                for (int j = 0; j < 2; ++j) { const int i = 2 * lane + 128 * j; *(unsigned*)(CKVN + (size_t)m * 256 + i) = pk2(xv[2 * j] * r * ap->in[17][i], xv[2 * j + 1] * r * ap->in[17][i + 1]); }
            }
            if (lane < 32) {
                const float xs = bf2f(hb[1944 + lane]), pr = bf2f(hb[1944 + (lane ^ 16)]); const float c_ = CS16[t * 32 + (lane & 15)], s_ = CS16[t * 32 + 16 + (lane & 15)];
                const float r = (lane < 16) ? xs * c_ - pr * s_ : xs * c_ + pr * s_;
                KR[(size_t)m * 32 + lane] = (bf16)f2bf(r);
            }
            LDS_WAIT(); asm volatile("" ::: "memory");
        }
    }
    PH_END
    PH_BEGIN
#if !defined(ONLY_G) || ONLY_G == 4
    { int Kq = 384; asm volatile("" : "+s"(Kq)); pg8::Gemm g{CQN, Wuq, M, 768, Kq}; pg8::StaticOrder S; S.init(M, 768, G, bx); pg8::EpiQmla E{QMLA, CS16};
      pg8::gemm_phase<pg8::EpiQmla, pg8::StaticOrder, true, true>(lds, g, S, E); }
#endif
#if !defined(ONLY_G) || ONLY_G == 5
    { int Kq = 1024; asm volatile("" : "+s"(Kq)); pg8::Gemm g{KV6 + 0 * KV6_SEG, W1k, 2048, 512, Kq}; pg8::StaticOrder S; S.init(2048, 512, G, (bx + G - 192 % G) % G); pg8::EpiF32 E{YK, 512};
      pg8::gemm_phase<pg8::EpiF32, pg8::StaticOrder, true, true>(lds, g, S, E); }
#endif
#if !defined(ONLY_G) || ONLY_G == 6
    { int Kq = 1024; asm volatile("" : "+s"(Kq)); pg8::Gemm g{KV6 + 1 * KV6_SEG, W1v, 2048, 512, Kq}; pg8::StaticOrder S; S.init(2048, 512, G, (bx + G - 208 % G) % G); pg8::EpiF32 E{YV, 512};
      pg8::gemm_phase<pg8::EpiF32, pg8::StaticOrder, true, true>(lds, g, S, E); }
#endif
#if !defined(ONLY_G) || ONLY_G == 7
    { int Kq = 256; asm volatile("" : "+s"(Kq)); pg8::Gemm g{CKVN, Wukv, M, 1024, Kq}; pg8::StaticOrder S; S.init(M, 1024, G, bx); pg8::EpiBf16<0> E{KVMLA, 1024, nullptr, 0, 0, 1.f};
      pg8::gemm_phase<pg8::EpiBf16<0>, pg8::StaticOrder, true, true>(lds, g, S, E); }
#endif
    PH_END
    PH_BEGIN
    {
        LAS float* hbuf = (LAS float*)(lds + wave * 1024);
        for (int idx = gw; idx < 2 * 4 * 512; idx += NGW) {
            const int kv = idx >> 11, bg = (idx >> 9) & 3, n = idx & 511;
            bf16* dst = (kv ? VCMP : KCMP) + ((size_t)bg * 512 + n) * 64;
            if (n == 511) { dst[lane] = 0; continue; }
            const float* Y = kv ? YV : YK; const float* pb = posb + kv * 256; const float* w2 = ap->in[kv ? 15 : 12];
#pragma unroll
            for (int i = 0; i < 4; ++i) { const int j = lane + 64 * i; const float p = Y[((size_t)bg * 512 + n) * 512 + j] + Y[((size_t)bg * 512 + n + 1) * 512 + 256 + j] + pb[j];
                const float y = 0.7978845608028654f * (p + 0.044715f * p * p * p); const float th = 1.f - 2.f / (expf(2.f * y) + 1.f); hbuf[j] = 0.5f * p * (1.f + th); }
            LDS_WAIT();
            float acc = 0.f;
#pragma unroll 8
            for (int j = 0; j < 256; ++j) acc += hbuf[j] * w2[j * 64 + lane];
            dst[lane] = (bf16)f2bf(acc);
            LDS_WAIT(); asm volatile("" ::: "memory");
        }
    }
    PH_END
    PH_BEGIN
    {
#ifndef NO_ATT
        for (int pi = bx; pi < 256; pi += G) {
#pragma nounroll
            for (int rep = 0; rep < 2; ++rep) {
                unsigned char* w2 = ws; asm volatile("" : "+s"(w2));
                const att::MlaPtrs MP{(const bf16*)(w2 + WS_QMLA), (const bf16*)(w2 + WS_KVMLA), (const bf16*)(w2 + WS_KR), (bf16*)(w2 + WS_U)};
                const int bh = pi >> 4, s = pi & 15; att::mla_item(lds, MP, bh >> 3, bh & 7, rep ? s : 31 - s, tid);
            }
#ifndef NO_NSA
#pragma nounroll
            for (int rep = 0; rep < 2; ++rep) {
                unsigned char* w2 = ws; asm volatile("" : "+s"(w2));
                const att::NsaPtrs NP{(const bf16*)(w2 + WS_QN), (const bf16*)(w2 + WS_KV6), (const bf16*)(w2 + WS_KCMP), (const bf16*)(w2 + WS_VCMP), (const float*)(w2 + WS_GATES), (bf16*)(w2 + WS_U)};
                const int bg = pi >> 6, s = pi & 63; att::nsa_item(lds, NP, bg >> 1, bg & 1, rep ? s : 127 - s, tid);
            }
#endif
        }
#endif
    }
    PH_END
    PH_BEGIN
#if !defined(ONLY_G) || ONLY_G == 8
    { int Kq = D; asm volatile("" : "+s"(Kq)); pg8::Gemm g{U, Wout, M, D, Kq}; pg8::StaticOrder S; S.init(M, D, G, bx); pg8::EpiResid E{XOUT, XOUT, mod + 5 * D, 1.0f};
      pg8::gemm_phase<pg8::EpiResid, pg8::StaticOrder, true, true>(lds, g, S, E); }
#endif
    PH_END
    PH_BEGIN
    row_pass<true, true>(XOUT, XOUT, ap->in[4] + 1 * D, ap->in[5] + 1 * D, mod, 6 * D, 7 * D, U, gw, NGW, lane);
    PH_END
    PH_BEGIN
#if !defined(ONLY_G) || ONLY_G == 9
    { int Kq = D; asm volatile("" : "+s"(Kq)); pg8::Gemm g{U, Wgu2, M, 2 * FF, Kq}; pg8::StaticOrder S; S.init(M, 2 * FF, G, bx); pg8::EpiSwiglu E{HFF, FF};
      pg8::gemm_phase<pg8::EpiSwiglu, pg8::StaticOrder, true, true>(lds, g, S, E); }
#endif
    PH_END
    PH_BEGIN
#if !defined(ONLY_G) || ONLY_G == 10
    { int Kq = FF; asm volatile("" : "+s"(Kq)); pg8::Gemm g{HFF, Wd2, M, D, Kq}; pg8::StaticOrder S; S.init(M, D, G, bx); pg8::EpiResid E{XOUT, XOUT, mod + 8 * D, 0.5f};
      pg8::gemm_phase<pg8::EpiResid, pg8::StaticOrder, true, true>(lds, g, S, E); }
#endif
    PH_END
    PH_BEGIN
    row_pass<true, false>(XOUT, XOUT, ap->in[4] + 2 * D, ap->in[5] + 2 * D, mod, 0, 0, U, gw, NGW, lane);
    }
}

#undef PH_BEGIN
#undef PH_END
#undef mod
#undef posb
#undef CS8
#undef CS16
#undef Wgu1
#undef Wd1
#undef Wgu2
#undef Wd2
#undef Win
#undef Wout
#undef Wuq
#undef Wukv
#undef W1k
#undef W1v
#undef KCMP
#undef VCMP
#undef YK
#undef YV
#undef GATES
#undef KR
#undef U
#undef HFF
#undef H
#undef QMLA
#undef KVMLA
#undef QN
#undef KV6
#undef CQN
#undef CKVN
#undef XIN
#undef XOUT

extern "C" void kernel_launch(void* const* d_in, const int* in_sizes, int n_in, void* d_out, int out_size, void* d_ws, size_t ws_size, hipStream_t stream) {
    static int grid = 0;
    if (grid == 0) {
        if (n_in != 24 || ws_size < WS_END) { fprintf(stderr, "kernel_launch: unexpected inputs (n_in %d, ws %zu)\n", n_in, ws_size); grid = -1; return; }
        int dev = 0, cus = 0, per_cu = 0;
        (void)hipGetDevice(&dev); (void)hipDeviceGetAttribute(&cus, hipDeviceAttributeMultiprocessorCount, dev);
        (void)hipFuncSetAttribute((const void*)mega_fwd, hipFuncAttributeMaxDynamicSharedMemorySize, LDS_BYTES);
        if (hipOccupancyMaxActiveBlocksPerMultiprocessor(&per_cu, (const void*)mega_fwd, NTHREADS, LDS_BYTES) != hipSuccess || per_cu < 1) { fprintf(stderr, "kernel_launch: occupancy query says %d\n", per_cu); per_cu = 1; }
        (void)hipGetLastError();
        grid = cus * per_cu;
    }
    if (grid < 0) return;
    Args a{};
    for (int i = 0; i < 24; ++i) a.in[i] = (const float*)d_in[i];
    a.out = (float*)d_out; a.ws = (unsigned char*)d_ws;
    const double two_pi = 6.283185307179586476925286766559;
    for (int i = 0; i < 8; ++i) a.inv8[i] = pow(500000.0, -(double)i / 8.0) / two_pi;
    for (int i = 0; i < 16; ++i) a.inv16[i] = pow(500000.0, -(double)i / 16.0) / two_pi;
    void* args[] = {&a};
    hipError_t e = hipLaunchCooperativeKernel((const void*)mega_fwd, dim3(grid), dim3(NTHREADS), args, LDS_BYTES, stream);
    if (e != hipSuccess) fprintf(stderr, "cooperative launch failed: %s (grid %d)\n", hipGetErrorString(e), grid);
}
```

```cpp
#include <hip/hip_runtime.h>
#include <hip/hip_cooperative_groups.h>
#include <cstdio>
#include <cstdint>
#include <cmath>
namespace cg = cooperative_groups;
namespace pg8 {
#define PG8_LAS __attribute__((address_space(3)))
typedef unsigned short bf16_t;
typedef short bf16x8 __attribute__((ext_vector_type(8)));
typedef float f32x4 __attribute__((ext_vector_type(4)));
typedef unsigned u32x4 __attribute__((ext_vector_type(4)));
constexpr int BM = 256, BK = 64, HALF = 128, HTB = HALF * BK * 2  , STAGE_BYTES = 8 * HTB, NXCD = 8, WGM = 8;

__host__ __device__ __forceinline__ int lds_byte(int r, int c) { const int st = (r >> 4) * 2 + (c >> 5), rr = r & 15, cc = c & 31, ob = rr * 64 + cc * 2; return st * 1024 + (ob ^ (((ob >> 9) & 1) << 5)); }
__host__ __device__ __forceinline__ void stage_rc(int b, int& R, int& C) { const int st = b / 1024, sb = b % 1024, swz = sb ^ (((sb >> 9) & 1) << 5); R = (st >> 1) * 16 + swz / 64; C = (st & 1) * 32 + (swz % 64) / 2; }
__host__ __device__ __forceinline__ int perm32(int rho) { const int n = rho >> 4, i = rho & 15; return 8 * (i >> 2) + 4 * n + (i & 3); }

struct Unit { int pm, pn; };
struct Gemm { const bf16_t* A; const bf16_t* Bt; int M, N, K; };

struct StaticOrder {
    int nM, nN, nwg, G, c;
    __host__ __device__ void init(int M, int N, int G_, int c_) { nM = M / BM; nN = N / BM; nwg = nM * nN; G = G_; c = c_; }
    __host__ __device__ bool next(int i, Unit& u) const {
        const long L = (long)i * G + c; if (L >= nwg) return false;
        int wgid = (int)L; { const int q = nwg / NXCD, r = nwg % NXCD, xcd = wgid % NXCD, off = wgid / NXCD; wgid = (xcd < r ? xcd * (q + 1) : r * (q + 1) + (xcd - r) * q) + off; }
        const int nig = WGM * nN, gid = wgid / nig, fm = gid * WGM, gsz = (nM - fm) < WGM ? (nM - fm) : WGM;
        u.pm = fm + ((wgid % nig) % gsz); u.pn = (wgid % nig) / gsz; return true;
    }
    __device__ __forceinline__ void a_ready(const Unit&) const {}
    __device__ __forceinline__ void done(const Unit&) const {}
};

__device__ __forceinline__ unsigned cvt_pk_bf16(float lo, float hi) { unsigned r; asm volatile("v_cvt_pk_bf16_f32 %0, %1, %2" : "=v"(r) : "v"(lo), "v"(hi)); return r; }
typedef float f32x2 __attribute__((ext_vector_type(2)));
__device__ __forceinline__ f32x2 gelu_pk(f32x2 v) {
    const f32x2 av = __builtin_elementwise_abs(v), d = av * 0.2316418882f + 1.0f;
    f32x2 t; t.x = __builtin_amdgcn_rcpf(d.x); t.y = __builtin_amdgcn_rcpf(d.y);
    f32x2 q = t * 0.5307027145f + (-0.7265760135f); q = q * t + 0.7107068705f; q = q * t + (-0.142248368f); q = q * t + 0.127414796f; q = q * t;
    const f32x2 s = (v * v) * (-0.72134752044f);
    f32x2 e; e.x = __builtin_amdgcn_exp2f(s.x); e.y = __builtin_amdgcn_exp2f(s.y);
    const f32x2 m = v * (q * e), r = v - m;
    f32x2 o; o.x = v.x < 0.f ? m.x : r.x; o.y = v.y < 0.f ? m.y : r.y; return o;
}

template <int ACT  > struct EpiBf16 {
    static constexpr bool PERM = true, AFTER_DRAIN = false; static_assert(ACT == 0 || ACT == 1, "EpiBf16: ACT is 0 (none) or 1 (gelu_pk)");
    bf16_t* O; int ldc; const float* bias; int split_cols; size_t split_stride; float scale0;
    __device__ __forceinline__ void operator()(const f32x4 (&acc)[2][2][4][2], const Unit& u, int wr, int wc, int fr, int fq) const {
        const int row0 = u.pm * BM + wr * 64 + fr; int colt = u.pn * BM; bf16_t* base = O;
        float sc = 1.f; if (split_cols) { const int t = colt / split_cols; base += (size_t)t * split_stride; colt -= t * split_cols; if (t == 0) sc = scale0; }
        const int col0 = colt + wc * 32 + 8 * fq, bcol0 = u.pn * BM + wc * 32 + 8 * fq;
        f32x4 bv[2][2];
#pragma unroll
        for (int bj = 0; bj < 2; ++bj)
#pragma unroll
            for (int n = 0; n < 2; ++n) bv[bj][n] = bias ? *(const f32x4*)(bias + bcol0 + bj * HALF + 4 * n) : (f32x4){0.f, 0.f, 0.f, 0.f};
#pragma unroll
        for (int ai = 0; ai < 2; ++ai)
#pragma unroll
            for (int m = 0; m < 4; ++m) { bf16_t* rowp = base + (size_t)(row0 + ai * HALF + m * 16) * ldc + col0;
#pragma unroll
                for (int bj = 0; bj < 2; ++bj) { f32x4 v0 = acc[ai][bj][m][0] + bv[bj][0], v1 = acc[ai][bj][m][1] + bv[bj][1];
                    if (ACT == 1) { f32x2 a = gelu_pk((f32x2){v0[0], v0[1]}), b = gelu_pk((f32x2){v0[2], v0[3]}), c = gelu_pk((f32x2){v1[0], v1[1]}), d = gelu_pk((f32x2){v1[2], v1[3]});
                        v0 = (f32x4){a.x, a.y, b.x, b.y}; v1 = (f32x4){c.x, c.y, d.x, d.y}; }
                    v0 = v0 * sc; v1 = v1 * sc; u32x4 w; w.x = cvt_pk_bf16(v0[0], v0[1]); w.y = cvt_pk_bf16(v0[2], v0[3]); w.z = cvt_pk_bf16(v1[0], v1[1]); w.w = cvt_pk_bf16(v1[2], v1[3]);
                    *(u32x4*)(rowp + bj * HALF) = w; } }
    }
};
template <class Epi, class Sched, bool ALIGN_EPI = false, bool SP2 = false>
__device__ __forceinline__ void gemm_phase(PG8_LAS unsigned char* lds, const Gemm g, const Sched& S, const Epi& E) {
    const int tid = threadIdx.x, wid = __builtin_amdgcn_readfirstlane(tid >> 6), lane = tid & 63, wr = wid >> 2, wc = wid & 3, fr = lane & 15, fq = lane >> 4;
    const int K = g.K, nt = K / BK;
    unsigned voffA[2], voffB[2];
#pragma unroll
    for (int i = 0; i < 2; ++i) { int R, C; stage_rc(tid * 16 + i * 8192, R, C); const int Rb = Epi::PERM ? ((R & ~31) + perm32(R & 31)) : R;
        voffA[i] = (unsigned)(R * K + C) * 2u; voffB[i] = (unsigned)(Rb * K + C) * 2u; }
    const size_t kstep = (size_t)(BK * 2);
    const size_t hstep = (size_t)HALF * K * 2;
    const size_t tstep = 2 * hstep;
    const unsigned ldsw = (unsigned)wid * 1024u;
    const int aoff = lds_byte(wr * 64 + fr, fq * 8), boff = lds_byte(wc * 32 + fr, fq * 8);
#define PG8_SA(b, h) (((b) * 2 + (h)) * HTB)
#define PG8_SB(b, h) ((4 + (b) * 2 + (h)) * HTB)
#define PG8_STAGE(bufoff, gbase, voff) do { _Pragma("unroll") for (int _i = 0; _i < 2; ++_i) \
        __builtin_amdgcn_global_load_lds((const unsigned*)((const char*)(gbase) + (voff)[_i]), (PG8_LAS unsigned*)(lds + (bufoff) + ldsw + _i * 8192), 16, 0, 0); } while (0)
#define PG8_LDA(dst, b, h) do { _Pragma("unroll") for (int m = 0; m < 4; ++m) _Pragma("unroll") for (int k = 0; k < 2; ++k) dst[m][k] = *(const PG8_LAS bf16x8*)(lds + PG8_SA(b, h) + aoff + m * 2048 + k * 1024); } while (0)
#define PG8_LDB(dst, b, h) do { _Pragma("unroll") for (int n = 0; n < 2; ++n) _Pragma("unroll") for (int k = 0; k < 2; ++k) dst[n][k] = *(const PG8_LAS bf16x8*)(lds + PG8_SB(b, h) + boff + n * 2048 + k * 1024); } while (0)
#define PG8_MMA(ai, bj, At, Bt) do { __builtin_amdgcn_s_setprio(1); _Pragma("unroll") for (int m = 0; m < 4; ++m) _Pragma("unroll") for (int n = 0; n < 2; ++n) _Pragma("unroll") for (int k = 0; k < 2; ++k) \
        acc[ai][bj][m][n] = __builtin_amdgcn_mfma_f32_16x16x32_bf16(Bt[n][k], At[m][k], acc[ai][bj][m][n], 0, 0, 0); __builtin_amdgcn_s_setprio(0); } while (0)
#define PG8_WAIT_V(n) asm volatile("s_waitcnt vmcnt(" #n ")" ::: "memory")
#define PG8_WAIT_L(n) asm volatile("s_waitcnt lgkmcnt(" #n ")" ::: "memory")
#define PG8_BAR __builtin_amdgcn_s_barrier()
#define PG8_SCHED __builtin_amdgcn_sched_barrier(0)
    Unit cur, nxt; int ui = 0;
    if (!S.next(0, cur)) return;
    f32x4 acc[2][2][4][2];
#pragma unroll
    for (int a = 0; a < 2; ++a)
#pragma unroll
        for (int b = 0; b < 2; ++b)
#pragma unroll
            for (int m = 0; m < 4; ++m)
#pragma unroll
                for (int n = 0; n < 2; ++n) acc[a][b][m][n] = (f32x4){0.f, 0.f, 0.f, 0.f};
    bf16x8 At[4][2], B0[2][2], B1[2][2];
    const char* cA = (const char*)g.A + (size_t)cur.pm * tstep; const char* cB = (const char*)g.Bt + (size_t)cur.pn * tstep;
    S.a_ready(cur);
    if constexpr (SP2) {
        PG8_STAGE(PG8_SB(0, 0), cB, voffB); PG8_STAGE(PG8_SB(0, 1), cB + hstep, voffB); PG8_STAGE(PG8_SA(0, 0), cA, voffA); PG8_STAGE(PG8_SA(0, 1), cA + hstep, voffA);
        if (wr == 1) PG8_BAR;
        PG8_WAIT_V(2); PG8_BAR;
        PG8_STAGE(PG8_SB(1, 0), cB + kstep, voffB); PG8_STAGE(PG8_SA(1, 0), cA + kstep, voffA); PG8_STAGE(PG8_SB(1, 1), cB + hstep + kstep, voffB);
        PG8_WAIT_V(6); PG8_BAR;
    } else {
        PG8_STAGE(PG8_SB(0, 0), cB, voffB); PG8_STAGE(PG8_SA(0, 0), cA, voffA); PG8_STAGE(PG8_SB(0, 1), cB + hstep, voffB); PG8_STAGE(PG8_SA(0, 1), cA + hstep, voffA);
        if (wr == 1) PG8_BAR;
        PG8_WAIT_V(4); PG8_BAR;
        PG8_STAGE(PG8_SB(1, 0), cB + kstep, voffB); PG8_STAGE(PG8_SA(1, 0), cA + kstep, voffA); PG8_STAGE(PG8_SB(1, 1), cB + hstep + kstep, voffB);
        PG8_WAIT_V(6); PG8_BAR;
    }
    for (;;) {
        const bool has_next = S.next(ui + 1, nxt);
        const char* nA = has_next ? (const char*)g.A + (size_t)nxt.pm * tstep : cA; const char* nB = has_next ? (const char*)g.Bt + (size_t)nxt.pn * tstep : cB;
        for (int t = 0; t < nt; t += 2) {
            const bool last = (t == nt - 2);
            const char* a1 = cA + (size_t)(t + 1) * kstep;
            const char* a2 = last ? nA : cA + (size_t)(t + 2) * kstep; const char* b2 = last ? nB : cB + (size_t)(t + 2) * kstep;
            const char* a3 = a2 + kstep; const char* b3 = b2 + kstep;
            if (last && has_next) S.a_ready(nxt);
            if constexpr (SP2) {
            PG8_LDB(B0, 0, 0); PG8_LDB(B1, 0, 1); PG8_SCHED; PG8_LDA(At, 0, 0); PG8_STAGE(PG8_SA(1, 1), a1 + hstep, voffA);
            PG8_WAIT_V(8); PG8_WAIT_L(0); PG8_BAR; PG8_MMA(0, 0, At, B0); PG8_MMA(0, 1, At, B1); PG8_BAR; PG8_SCHED;
            PG8_LDA(At, 0, 1); PG8_STAGE(PG8_SB(0, 0), b2, voffB); PG8_STAGE(PG8_SB(0, 1), b2 + hstep, voffB); PG8_STAGE(PG8_SA(0, 0), a2, voffA);
            PG8_WAIT_V(8); PG8_WAIT_L(0); PG8_BAR; PG8_MMA(1, 0, At, B0); PG8_MMA(1, 1, At, B1); PG8_BAR; PG8_SCHED;
            PG8_LDB(B0, 1, 0); PG8_LDB(B1, 1, 1); PG8_SCHED; PG8_LDA(At, 1, 0); PG8_STAGE(PG8_SA(0, 1), a2 + hstep, voffA);
            PG8_WAIT_V(8); PG8_WAIT_L(0); PG8_BAR; PG8_MMA(0, 0, At, B0); PG8_MMA(0, 1, At, B1); PG8_BAR; PG8_SCHED;
            PG8_LDA(At, 1, 1); PG8_STAGE(PG8_SB(1, 0), b3, voffB); PG8_STAGE(PG8_SB(1, 1), b3 + hstep, voffB); PG8_STAGE(PG8_SA(1, 0), a3, voffA);
            PG8_WAIT_V(8); PG8_WAIT_L(0); PG8_BAR; PG8_MMA(1, 0, At, B0); PG8_MMA(1, 1, At, B1); PG8_BAR; PG8_SCHED;
            } else {
            PG8_LDB(B0, 0, 0); PG8_SCHED; PG8_LDA(At, 0, 0); PG8_STAGE(PG8_SA(1, 1), a1 + hstep, voffA);
            PG8_WAIT_L(8); PG8_BAR; PG8_WAIT_L(0); PG8_MMA(0, 0, At, B0); PG8_BAR; PG8_SCHED;
            PG8_LDB(B1, 0, 1); PG8_STAGE(PG8_SB(0, 0), b2, voffB);
            PG8_BAR; PG8_WAIT_L(0); PG8_MMA(0, 1, At, B1); PG8_BAR;
            PG8_LDA(At, 0, 1); PG8_STAGE(PG8_SA(0, 0), a2, voffA);
            PG8_BAR; PG8_WAIT_L(0); PG8_MMA(1, 0, At, B0); PG8_BAR; PG8_SCHED;
            PG8_STAGE(PG8_SB(0, 1), b2 + hstep, voffB);
            PG8_WAIT_V(6); PG8_BAR; PG8_MMA(1, 1, At, B1); PG8_BAR;
            PG8_LDB(B0, 1, 0); PG8_SCHED; PG8_LDA(At, 1, 0); PG8_STAGE(PG8_SA(0, 1), a2 + hstep, voffA);
            PG8_WAIT_L(8); PG8_BAR; PG8_WAIT_L(0); PG8_MMA(0, 0, At, B0); PG8_BAR; PG8_SCHED;
            PG8_LDB(B1, 1, 1); PG8_STAGE(PG8_SB(1, 0), b3, voffB);
            PG8_BAR; PG8_WAIT_L(0); PG8_MMA(0, 1, At, B1); PG8_BAR;
            PG8_LDA(At, 1, 1); PG8_STAGE(PG8_SA(1, 0), a3, voffA);
            PG8_BAR; PG8_WAIT_L(0); PG8_MMA(1, 0, At, B0); PG8_BAR; PG8_SCHED;
            PG8_STAGE(PG8_SB(1, 1), b3 + hstep, voffB);
            PG8_WAIT_V(6); PG8_BAR; PG8_MMA(1, 1, At, B1); PG8_BAR;
            }
        }
        if constexpr (ALIGN_EPI) { if (wr == 0) PG8_BAR; }
        if constexpr (!Epi::AFTER_DRAIN) { E(acc, cur, wr, wc, fr, fq); S.done(cur); }
        if (!has_next) break;
#pragma unroll
        for (int a = 0; a < 2; ++a)
#pragma unroll
            for (int b = 0; b < 2; ++b)
#pragma unroll
                for (int m = 0; m < 4; ++m)
#pragma unroll
                    for (int n = 0; n < 2; ++n) acc[a][b][m][n] = (f32x4){0.f, 0.f, 0.f, 0.f};
        cur = nxt; cA = nA; cB = nB; ++ui;
        if constexpr (ALIGN_EPI) { if (wr == 1) PG8_BAR; }
    }
    PG8_WAIT_V(0);
    if constexpr (!ALIGN_EPI) { if (wr == 0) PG8_BAR; }
    PG8_BAR;
    if constexpr (Epi::AFTER_DRAIN) { E.fused(acc, cur, wr, wc, fr, fq, lds, wid, lane); S.done(cur); }
#undef PG8_SA
#undef PG8_SB
#undef PG8_STAGE
#undef PG8_LDA
#undef PG8_LDB
#undef PG8_MMA
#undef PG8_WAIT_V
#undef PG8_WAIT_L
#undef PG8_BAR
#undef PG8_SCHED
}
}

#define LAS __attribute__((address_space(3)))
typedef unsigned short bf16;
typedef unsigned v4u __attribute__((ext_vector_type(4)));
typedef unsigned v2u __attribute__((ext_vector_type(2)));
typedef float f32x4 __attribute__((ext_vector_type(4)));
typedef short bf16x8 __attribute__((ext_vector_type(8)));
typedef short s16x4 __attribute__((ext_vector_type(4)));
#define LDS_WAIT() asm volatile("s_waitcnt lgkmcnt(0)" ::: "memory")

constexpr int BATCH = 2, T = 8192, D = 1024, M = BATCH * T, FF = 2816, DIN = 1976, DINP = 2048, NMOD = 9 * D;
constexpr float ALPHA = 1.18920711500272f;
constexpr float LN_EPS = 1e-5f;
constexpr float QS_NSA = 0.125f * 1.4426950408889634f;
constexpr float QS_MLA = 0.10206207261596575f * 1.4426950408889634f;
constexpr int LDS_BYTES = 147456;
constexpr int NTHREADS = 512;

constexpr size_t MiB = 1u << 20;
constexpr size_t WS_CTL = 832 * 1024, CTL_BYTES = 16 * 1024;
constexpr size_t WS_MOD = 0, WS_POSB = 128 * 1024, WS_CS8 = 256 * 1024, WS_CS16 = 57 * MiB;
constexpr size_t WS_WGU1 = 1 * MiB, WS_WD1 = 12 * MiB, WS_WGU2 = 18 * MiB, WS_WD2 = 29 * MiB, WS_WIN = 35 * MiB, WS_WOUT = 39 * MiB, WS_WUQ = 41 * MiB, WS_WUKV = 42 * MiB,
                 WS_W1K = 43 * MiB, WS_W1V = 44 * MiB, WS_KCMP = 45 * MiB, WS_VCMP = 45 * MiB + 512 * 1024, WS_YK = 46 * MiB, WS_YV = 50 * MiB, WS_GATES = 54 * MiB, WS_KR = 56 * MiB,
                 WS_U = 58 * MiB, WS_BIG = 90 * MiB;
constexpr size_t WS_HFF = WS_BIG, WS_H = WS_BIG, WS_QMLA = WS_BIG, WS_KVMLA = WS_BIG + 24 * MiB, WS_QN = WS_BIG + 64 * MiB, WS_KV6 = WS_BIG + 80 * MiB, WS_CQN = WS_BIG + 104 * MiB, WS_CKVN = WS_BIG + 116 * MiB;
constexpr size_t KV6_SEG = (size_t)BATCH * 2 * T * 64;
constexpr size_t WS_END = WS_BIG + 124 * MiB;
static_assert(WS_END <= 256 * MiB, "ws map");

struct Args { const float* in[24]; float* out; unsigned char* ws; double inv8[8]; double inv16[16]; };

__device__ __forceinline__ float wave_sum(float v) {
#pragma unroll
    for (int o = 1; o < 64; o <<= 1) v += __shfl_xor(v, o);
    return v;
}
__device__ __forceinline__ unsigned f2bf(float f) { unsigned u = __builtin_bit_cast(unsigned, f); return (u + 0x7fffu + ((u >> 16) & 1u)) >> 16; }
__device__ __forceinline__ unsigned pk2(float lo, float hi) { return f2bf(lo) | (f2bf(hi) << 16); }
__device__ __forceinline__ float bf2f(unsigned short h) { return __builtin_bit_cast(float, (unsigned)h << 16); }
__device__ __forceinline__ void rope_cs(int pos, double invrev, float& c, float& s) {
    double a = (double)pos * invrev; a -= __builtin_floor(a); const float f = (float)a;
    s = __builtin_amdgcn_sinf(f); c = __builtin_amdgcn_cosf(f);
}

namespace pg8 {
struct EpiSwiglu {
    static constexpr bool PERM = true, AFTER_DRAIN = false;
    bf16_t* O; int ldc;
    __device__ __forceinline__ void operator()(const f32x4 (&acc)[2][2][4][2], const Unit& u, int wr, int wc, int fr, int fq) const {
        const int row0 = u.pm * BM + wr * 64 + fr, col0 = u.pn * 128 + wc * 32 + 8 * fq;
#pragma unroll
        for (int ai = 0; ai < 2; ++ai)
#pragma unroll
            for (int m = 0; m < 4; ++m) {
                bf16_t* rowp = O + (size_t)(row0 + ai * HALF + m * 16) * ldc + col0;
                float h[8];
#pragma unroll
                for (int n = 0; n < 2; ++n)
#pragma unroll
                    for (int e = 0; e < 4; ++e) { const float g = acc[ai][0][m][n][e], up = acc[ai][1][m][n][e]; h[4 * n + e] = g * __builtin_amdgcn_rcpf(1.f + __expf(-g)) * up; }
                u32x4 w; w.x = cvt_pk_bf16(h[0], h[1]); w.y = cvt_pk_bf16(h[2], h[3]); w.z = cvt_pk_bf16(h[4], h[5]); w.w = cvt_pk_bf16(h[6], h[7]);
                *(u32x4*)rowp = w;
            }
    }
};
struct EpiResid {
    static constexpr bool PERM = false, AFTER_DRAIN = false;
    const float* xin; float* out; const float* gate; float coef;
    __device__ __forceinline__ void operator()(const f32x4 (&acc)[2][2][4][2], const Unit& u, int wr, int wc, int fr, int fq) const {
        const int row0 = u.pm * BM + wr * 64 + fr, col0 = u.pn * BM + wc * 32 + 4 * fq;
#pragma unroll
        for (int ai = 0; ai < 2; ++ai)
#pragma unroll
            for (int m = 0; m < 4; ++m) {
                const int row = row0 + ai * HALF + m * 16; const int b = row >> 13;
#pragma unroll
                for (int bj = 0; bj < 2; ++bj)
#pragma unroll
                    for (int n = 0; n < 2; ++n) {
                        const int col = col0 + bj * HALF + n * 16;
                        const f32x4 gv = *(const f32x4*)(gate + (size_t)b * 9216 + col);
                        const f32x4 xv = *(const f32x4*)(xin + (size_t)row * 1024 + col);
                        const f32x4 o = xv * ALPHA + (gv + 1.0f) * coef * acc[ai][bj][m][n];
                        *(f32x4*)(out + (size_t)row * 1024 + col) = o;
                    }
            }
    }
};
struct EpiF32 {
    static constexpr bool PERM = false, AFTER_DRAIN = false;
    float* out; int ldc;
    __device__ __forceinline__ void operator()(const f32x4 (&acc)[2][2][4][2], const Unit& u, int wr, int wc, int fr, int fq) const {
        const int row0 = u.pm * BM + wr * 64 + fr, col0 = u.pn * BM + wc * 32 + 4 * fq;
#pragma unroll
        for (int ai = 0; ai < 2; ++ai)
#pragma unroll
            for (int m = 0; m < 4; ++m)
#pragma unroll
                for (int bj = 0; bj < 2; ++bj)
#pragma unroll
                    for (int n = 0; n < 2; ++n) *(f32x4*)(out + (size_t)(row0 + ai * HALF + m * 16) * ldc + col0 + bj * HALF + n * 16) = acc[ai][bj][m][n];
    }
};
struct EpiQmla {
    static constexpr bool PERM = false, AFTER_DRAIN = false;
    bf16_t* O; const float* cst;
    __device__ __forceinline__ void operator()(const f32x4 (&acc)[2][2][4][2], const Unit& u, int wr, int wc, int fr, int fq) const {
        const int row0 = u.pm * BM + wr * 64 + fr, col0 = u.pn * BM + wc * 32 + 4 * fq;
        if (u.pn < 2) {
#pragma unroll
            for (int ai = 0; ai < 2; ++ai)
#pragma unroll
                for (int m = 0; m < 4; ++m)
#pragma unroll
                    for (int bj = 0; bj < 2; ++bj)
#pragma unroll
                        for (int n = 0; n < 2; ++n) { const f32x4 v = acc[ai][bj][m][n] * QS_MLA; unsigned lo = cvt_pk_bf16(v[0], v[1]), hi = cvt_pk_bf16(v[2], v[3]);
                            unsigned long long w = (unsigned long long)lo | ((unsigned long long)hi << 32);
                            *(unsigned long long*)(O + (size_t)(row0 + ai * HALF + m * 16) * 768 + col0 + bj * HALF + n * 16) = w; }
        } else {
#pragma unroll
            for (int ai = 0; ai < 2; ++ai)
#pragma unroll
                for (int m = 0; m < 4; ++m) {
                    const int row = row0 + ai * HALF + m * 16; const int pos = row & 8191;
                    const f32x4 cs = *(const f32x4*)(cst + (size_t)pos * 32 + 4 * fq), sn = *(const f32x4*)(cst + (size_t)pos * 32 + 16 + 4 * fq);
#pragma unroll
                    for (int bj = 0; bj < 2; ++bj) {
                        const f32x4 x1 = acc[ai][bj][m][0], x2 = acc[ai][bj][m][1];
                        const f32x4 o1 = (x1 * cs - x2 * sn) * QS_MLA, o2 = (x2 * cs + x1 * sn) * QS_MLA;
                        bf16_t* p = O + (size_t)row * 768 + col0 + bj * HALF;
                        *(unsigned long long*)(p) = (unsigned long long)cvt_pk_bf16(o1[0], o1[1]) | ((unsigned long long)cvt_pk_bf16(o1[2], o1[3]) << 32);
                        *(unsigned long long*)(p + 16) = (unsigned long long)cvt_pk_bf16(o2[0], o2[1]) | ((unsigned long long)cvt_pk_bf16(o2[2], o2[3]) << 32);
                    }
                }
        }
    }
};
}

namespace att {
constexpr int OFF_K = 0, OFF_V = 13312, OFF_SEL = 22528, OFF_IMP = 23552, OFF_OC = OFF_IMP + 64 * 132 * 4, OFF_END = OFF_OC + 8 * 512 * 16;
static_assert(OFF_END <= 147456 && OFF_OC % 16 == 0, "attention LDS map");
constexpr int VSTR = 72, ISTR = 132;
enum { CAUSAL = 0, WINDOW = 1, CMP = 2, SEL = 3 };
constexpr float NEG = -1e30f;

template <int DQK> struct Stage { v4u k0, k1, v; };

template <int DQK> __device__ __forceinline__ void stage_load(Stage<DQK>& s, const bf16* K0, int p0, const bf16* K1, int p1, const bf16* V, int pv, int tile, bool withV, int tid) {
    { const int key = tid >> 3, c = tid & 7; s.k0 = *(const v4u*)(K0 + (size_t)(64 * tile + key) * p0 + 8 * c); }
    if (DQK == 96) { if (tid < 256) { const int key = tid >> 2, c = tid & 3; s.k1 = *(const v4u*)(K1 + (size_t)(64 * tile + key) * p1 + 8 * c); } }
    if (withV) { const int w = tid >> 6, ky = tid & 63; s.v = *(const v4u*)(V + (size_t)(64 * tile + ky) * pv + 8 * w); }
}
template <int DQK> __device__ __forceinline__ void stage_store(const Stage<DQK>& s, LAS unsigned char* lds, bool withV, int tid) {
    constexpr int KSTR = DQK + 8;
    { const int key = tid >> 3, c = tid & 7; *(LAS v4u*)(lds + OFF_K + (key * KSTR + 8 * c) * 2) = s.k0; }
    if (DQK == 96) { if (tid < 256) { const int key = tid >> 2, c = tid & 3; *(LAS v4u*)(lds + OFF_K + (key * KSTR + 64 + 8 * c) * 2) = s.k1; } }
    if (withV) { const int w = tid >> 6, ky = tid & 63; LAS unsigned short* vt = (LAS unsigned short*)(lds + OFF_V);
#pragma unroll
        for (int e = 0; e < 8; ++e) vt[(8 * w + e) * VSTR + ky] = (unsigned short)((s.v[e >> 1] >> (16 * (e & 1))) & 0xffffu); }
}

template <int DQK> __device__ __forceinline__ void qk_tile(LAS unsigned char* lds, const bf16x8 (&qf)[DQK / 32], f32x4 (&s)[4], int fr, int fq) {
    constexpr int KSTR = DQK + 8, NKS = DQK / 32;
#pragma unroll
    for (int ss = 0; ss < 4; ++ss) {
        s[ss] = (f32x4){0.f, 0.f, 0.f, 0.f};
#pragma unroll
        for (int ks = 0; ks < NKS; ++ks) {
            const bf16x8 kf = *(const LAS bf16x8*)(lds + OFF_K + ((16 * ss + fr) * KSTR + 32 * ks + 8 * fq) * 2);
            s[ss] = __builtin_amdgcn_mfma_f32_16x16x32_bf16(kf, qf[ks], s[ss], 0, 0, 0);
        }
    }
}
template <int MODE> __device__ __forceinline__ bool key_ok(int kpos, int tpos, bool rowsel) {
    if (MODE == CAUSAL) return kpos <= tpos;
    if (MODE == WINDOW) return kpos <= tpos && kpos + 512 > tpos;
    if (MODE == CMP) return 16 * kpos + 31 <= tpos;
    return rowsel && kpos <= tpos;
}
template <int DQK, int MODE> __device__ __forceinline__ void qt_tile(LAS unsigned char* lds, const bf16x8 (&qf)[DQK / 32], int kbase, int tpos, bool rowsel, float& m, float& l, f32x4 (&o)[4], int fr, int fq) {
    f32x4 s[4];
    __builtin_amdgcn_sched_barrier(0);
    qk_tile<DQK>(lds, qf, s, fr, fq);
    __builtin_amdgcn_sched_barrier(0);
    float mx = NEG;
#pragma unroll
    for (int ss = 0; ss < 4; ++ss)
#pragma unroll
        for (int i = 0; i < 4; ++i) { const bool ok = key_ok<MODE>(kbase + 16 * ss + 4 * fq + i, tpos, rowsel); const float v = ok ? s[ss][i] : NEG; s[ss][i] = v; mx = fmaxf(mx, v); }
    mx = fmaxf(mx, __shfl_xor(mx, 16)); mx = fmaxf(mx, __shfl_xor(mx, 32));
    const float mnew = fmaxf(m, mx);
    const float alpha = __builtin_amdgcn_exp2f(m - mnew);
    float rs = 0.f;
#pragma unroll
    for (int ss = 0; ss < 4; ++ss)
#pragma unroll
        for (int i = 0; i < 4; ++i) { const float v = s[ss][i]; const float p = (v > -1e29f) ? __builtin_amdgcn_exp2f(v - mnew) : 0.f; s[ss][i] = p; rs += p; }
    l = l * alpha + rs; m = mnew;
#pragma unroll
    for (int dt = 0; dt < 4; ++dt) o[dt] = o[dt] * alpha;
    bf16x8 pb[2];
#pragma unroll
    for (int j = 0; j < 2; ++j) {
        const unsigned a0 = pk2(s[2 * j][0], s[2 * j][1]), a1 = pk2(s[2 * j][2], s[2 * j][3]), a2 = pk2(s[2 * j + 1][0], s[2 * j + 1][1]), a3 = pk2(s[2 * j + 1][2], s[2 * j + 1][3]);
        const v4u w = (v4u){a0, a1, a2, a3}; pb[j] = __builtin_bit_cast(bf16x8, w);
    }
    __builtin_amdgcn_sched_barrier(0);
#pragma unroll
    for (int dt = 0; dt < 4; ++dt)
#pragma unroll
        for (int j = 0; j < 2; ++j) {
            const LAS unsigned char* vp = lds + OFF_V + ((16 * dt + fr) * VSTR + 32 * j + 4 * fq) * 2;
            const v2u lo = *(const LAS v2u*)vp, hi = *(const LAS v2u*)(vp + 32);
            const v4u w = (v4u){lo.x, lo.y, hi.x, hi.y};
            o[dt] = __builtin_amdgcn_mfma_f32_16x16x32_bf16(__builtin_bit_cast(bf16x8, w), pb[j], o[dt], 0, 0, 0);
        }
    __builtin_amdgcn_sched_barrier(0);
}

template <int DQK, int MODE> __device__ __forceinline__ void attn_pass(LAS unsigned char* lds, const bf16* K0, int p0, const bf16* K1, int p1, const bf16* V, int pv, int tlo, int thi,
        const bf16x8 (&qf)[2][DQK / 32], const int (&tpos)[2], const int (&tok)[2], int wave_tmax, f32x4 (&o)[2][4], float (&mfin)[2], float (&linv)[2], int tid, int fr, int fq) {
    asm volatile("" : "+v"(tid)); asm volatile("" : "+s"(K0), "+s"(V)); if (DQK == 96) asm volatile("" : "+s"(K1));
    fr = tid & 15; fq = (tid & 63) >> 4;
    float m[2] = {NEG, NEG}, l[2] = {0.f, 0.f};
#pragma unroll
    for (int i = 0; i < 2; ++i)
#pragma unroll
        for (int dt = 0; dt < 4; ++dt) o[i][dt] = (f32x4){0.f, 0.f, 0.f, 0.f};
    Stage<DQK> st;
    stage_load<DQK>(st, K0, p0, K1, p1, V, pv, tlo, true, tid);
    for (int t = tlo; t <= thi; ++t) {
        __syncthreads();
        stage_store<DQK>(st, lds, true, tid);
        __syncthreads();
        if (t < thi) stage_load<DQK>(st, K0, p0, K1, p1, V, pv, t + 1, true, tid);
        const int kbase = 64 * t;
        const bool skip = (MODE == CMP) ? (16 * kbase + 31 > wave_tmax) : (kbase > wave_tmax);
        if (!skip) {
#pragma unroll
            for (int i = 0; i < 2; ++i) {
                bool rowsel = true;
                if (MODE == SEL) { const unsigned w = ((const LAS unsigned*)(lds + OFF_SEL))[tok[i] * 4 + (t >> 5)]; rowsel = ((w >> (t & 31)) & 1u) != 0u; if (!__any(rowsel ? 1 : 0)) continue; }
                qt_tile<DQK, MODE>(lds, qf[i], kbase, tpos[i], rowsel, m[i], l[i], o[i], fr, fq);
            }
        }
    }
#pragma unroll
    for (int i = 0; i < 2; ++i) {
        float lt = l[i]; lt += __shfl_xor(lt, 16); lt += __shfl_xor(lt, 32);
        const float iv = lt > 0.f ? 1.0f / lt : 0.f;
        mfin[i] = m[i]; linv[i] = iv;
#pragma unroll
        for (int dt = 0; dt < 4; ++dt) o[i][dt] = o[i][dt] * iv;
    }
}

struct NsaPtrs { const bf16 *QN, *KV6, *KCMP, *VCMP; const float* GATES; bf16* OCAT; };

__device__ __forceinline__ void nsa_load_q(const bf16* QN, int b, int g, int tid, int t0, bf16x8 (&qf)[2][2]) {
    asm volatile("" : "+v"(tid)); asm volatile("" : "+s"(QN));
    const int wave = tid >> 6, fr = tid & 15, fq = (tid & 63) >> 4, hh = fr >> 2;
#pragma unroll
    for (int i = 0; i < 2; ++i) {
        const size_t mrow = (size_t)b * T + t0 + 8 * wave + 4 * i + (fr & 3);
        const bf16* qrow = QN + mrow * 512 + (g * 4 + hh) * 64;
#pragma unroll
        for (int ks = 0; ks < 2; ++ks) qf[i][ks] = *(const bf16x8*)(qrow + 32 * ks + 8 * fq);
    }
}
__device__ __forceinline__ void nsa_item(LAS unsigned char* lds, const NsaPtrs& P, int b, int g, int qb, int tid) {
    const int wave = tid >> 6, lane = tid & 63, fr = lane & 15, fq = lane >> 4, hh = fr >> 2;
    const int t0 = 64 * qb; const size_t bg = (size_t)(b * 2 + g);
    int tpos[2], tok[2];
#pragma unroll
    for (int i = 0; i < 2; ++i) { tok[i] = 8 * wave + 4 * i + (fr & 3); tpos[i] = t0 + tok[i]; }
    const int wave_tmax = t0 + 8 * wave + 7;
    LAS float* imp = (LAS float*)(lds + OFF_IMP);
    LAS f32x4* ocl = (LAS f32x4*)(lds + OFF_OC);
    for (int idx = tid; idx < 64 * ISTR; idx += NTHREADS) imp[idx] = 0.f;
    bf16x8 qf[2][2]; f32x4 o[2][4]; float mf[2], li[2];
    const bf16* Kc = P.KCMP + bg * 512 * 64; const bf16* Vc = P.VCMP + bg * 512 * 64;
    const int thi_c = ((t0 + 63 - 31) >> 4) >> 6;
    nsa_load_q(P.QN, b, g, tid, t0, qf);
    attn_pass<64, CMP>(lds, Kc, 64, nullptr, 0, Vc, 64, 0, thi_c, qf, tpos, tok, wave_tmax, o, mf, li, tid, fr, fq);
#pragma unroll
    for (int i = 0; i < 2; ++i) { const float gc = P.GATES[((size_t)b * T + tpos[i]) * 24 + g * 12 + hh * 3 + 0];
#pragma unroll
        for (int dt = 0; dt < 4; ++dt) ocl[(i * 4 + dt) * NTHREADS + tid] = o[i][dt] * gc; }
#ifndef NSA_NO_IMP
    int tid_i = tid; asm volatile("" : "+v"(tid_i)); const int fr_i = tid_i & 15, fq_i = (tid_i & 63) >> 4; asm volatile("" : "+s"(Kc));
    for (int t = 0; t <= thi_c; ++t) {
        __syncthreads();
        { const int key = tid_i >> 3, c = tid_i & 7; *(LAS v4u*)(lds + OFF_K + (key * 72 + 8 * c) * 2) = *(const v4u*)(Kc + (size_t)(64 * t + key) * 64 + 8 * c); }
        __syncthreads();
        if (16 * (64 * t) + 31 > wave_tmax) continue;
#pragma unroll
        for (int i = 0; i < 2; ++i) {
            f32x4 s[4];
            qk_tile<64>(lds, qf[i], s, fr_i, fq_i);
#pragma unroll
            for (int ss = 0; ss < 4; ++ss) {
                float a = 0.f, b3 = 0.f;
#pragma unroll
                for (int e = 0; e < 4; ++e) { const int n = 64 * t + 16 * ss + 4 * fq_i + e; const float p = (16 * n + 31 <= tpos[i]) ? __builtin_amdgcn_exp2f(s[ss][e] - mf[i]) * li[i] : 0.f; a += p; if (e == 3) b3 = p; }
                a += __shfl_xor(a, 4); a += __shfl_xor(a, 8); b3 += __shfl_xor(b3, 4); b3 += __shfl_xor(b3, 8);
                if (fr_i < 4) { const int jp = 16 * t + 4 * ss + fq_i;
                    __hip_atomic_fetch_add(imp + tok[i] * ISTR + jp, a, __ATOMIC_RELAXED, __HIP_MEMORY_SCOPE_WORKGROUP);
                    __hip_atomic_fetch_add(imp + tok[i] * ISTR + jp + 1, b3, __ATOMIC_RELAXED, __HIP_MEMORY_SCOPE_WORKGROUP); }
            }
        }
    }
#endif
    __syncthreads();
#ifndef NSA_NO_TOPK
    {
        int tid_k = tid; asm volatile("" : "+v"(tid_k)); const int tk = tid_k >> 3, part = tid_k & 7;
        float v[16]; int cnt[16];
#pragma unroll
        for (int jj = 0; jj < 16; ++jj) { const int j = part * 16 + jj; const bool causal = j <= qb, forced = (j == 0) || (j == qb) || (j == qb - 1);
            const float val = !causal ? -1.0f : (forced ? 1e9f : imp[tk * ISTR + j]); v[jj] = val; cnt[jj] = 0; }
        __syncthreads();
#pragma unroll
        for (int jj = 0; jj < 16; ++jj) imp[tk * ISTR + part * 16 + jj] = v[jj];
        __syncthreads();
        for (int k = 0; k <= qb; ++k) { const float vk = imp[tk * ISTR + k];
#pragma unroll
            for (int jj = 0; jj < 16; ++jj) { const int j = part * 16 + jj; cnt[jj] += ((vk > v[jj]) || (vk == v[jj] && k < j)) ? 1 : 0; } }
        unsigned bits = 0u;
#pragma unroll
        for (int jj = 0; jj < 16; ++jj) { const int j = part * 16 + jj; if (j <= qb && cnt[jj] < 16) bits |= (1u << jj); }
        ((LAS unsigned short*)(lds + OFF_SEL))[tk * 8 + part] = (unsigned short)bits;
    }
#endif
    __syncthreads();
#ifndef NSA_NO_SEL
    nsa_load_q(P.QN, b, g, tid, t0, qf);
    attn_pass<64, SEL>(lds, P.KV6 + 2 * KV6_SEG + bg * T * 64, 64, nullptr, 0, P.KV6 + 3 * KV6_SEG + bg * T * 64, 64, 0, qb, qf, tpos, tok, wave_tmax, o, mf, li, tid, fr, fq);
#pragma unroll
    for (int i = 0; i < 2; ++i) { const float gs = P.GATES[((size_t)b * T + tpos[i]) * 24 + g * 12 + hh * 3 + 1];
#pragma unroll
        for (int dt = 0; dt < 4; ++dt) ocl[(i * 4 + dt) * NTHREADS + tid] += o[i][dt] * gs; }
#endif
    nsa_load_q(P.QN, b, g, tid, t0, qf);
    attn_pass<64, WINDOW>(lds, P.KV6 + 4 * KV6_SEG + bg * T * 64, 64, nullptr, 0, P.KV6 + 5 * KV6_SEG + bg * T * 64, 64, (qb >= 8 ? qb - 8 : 0), qb, qf, tpos, tok, wave_tmax, o, mf, li, tid, fr, fq);
#pragma unroll
    for (int i = 0; i < 2; ++i) {
        const float gw = P.GATES[((size_t)b * T + tpos[i]) * 24 + g * 12 + hh * 3 + 2];
        bf16* orow = P.OCAT + ((size_t)b * T + tpos[i]) * 1024 + (g * 4 + hh) * 64 + 4 * fq;
#pragma unroll
        for (int dt = 0; dt < 4; ++dt) { const f32x4 r = ocl[(i * 4 + dt) * NTHREADS + tid] + o[i][dt] * gw;
            *(unsigned long long*)(orow + 16 * dt) = (unsigned long long)pk2(r[0], r[1]) | ((unsigned long long)pk2(r[2], r[3]) << 32); }
    }
}

struct MlaPtrs { const bf16 *QMLA, *KVMLA, *KR; bf16* OCAT; };
__device__ __forceinline__ void mla_item(LAS unsigned char* lds, const MlaPtrs& P, int b, int h, int qb, int tid) {
    const int wave = tid >> 6, lane = tid & 63, fr = lane & 15, fq = lane >> 4;
    const int t0 = 256 * qb;
    int tpos[2], tok[2]; bf16x8 qf[2][3];
#pragma unroll
    for (int i = 0; i < 2; ++i) {
        tok[i] = 0; tpos[i] = t0 + 32 * wave + 16 * i + fr;
        const bf16* qrow = P.QMLA + ((size_t)b * T + tpos[i]) * 768;
        qf[i][0] = *(const bf16x8*)(qrow + h * 64 + 8 * fq); qf[i][1] = *(const bf16x8*)(qrow + h * 64 + 32 + 8 * fq); qf[i][2] = *(const bf16x8*)(qrow + 512 + h * 32 + 8 * fq);
    }
    const int wave_tmax = t0 + 32 * wave + 31;
    f32x4 o[2][4]; float mf[2], li[2];
    const bf16* kv = P.KVMLA + (size_t)b * T * 1024;
    attn_pass<96, CAUSAL>(lds, kv + h * 64, 1024, P.KR + (size_t)b * T * 32, 32, kv + 512 + h * 64, 1024, 0, 4 * qb + 3, qf, tpos, tok, wave_tmax, o, mf, li, tid, fr, fq);
#pragma unroll
    for (int i = 0; i < 2; ++i) {
        bf16* orow = P.OCAT + ((size_t)b * T + tpos[i]) * 1024 + 512 + h * 64 + 4 * fq;
#pragma unroll
        for (int dt = 0; dt < 4; ++dt) { const f32x4 r = o[i][dt];
            *(unsigned long long*)(orow + 16 * dt) = (unsigned long long)pk2(r[0], r[1]) | ((unsigned long long)pk2(r[2], r[3]) << 32); }
    }
}
}

__device__ __forceinline__ void tr_item(const float* W, int N, int k0, int n0, bf16* WT, int Kd, int drow0, int dk0, LAS float* scr, int lane) {
#pragma unroll 8
    for (int i = 0; i < 32; ++i) { const int kk = 2 * i + (lane >> 5); const int n = n0 + (lane & 31); scr[kk * 33 + (lane & 31)] = (n < N) ? W[(size_t)(k0 + kk) * N + n] : 0.f; }
    LDS_WAIT();
    const int c = lane & 7;
#pragma unroll
    for (int j = 0; j < 4; ++j) { const int n = (lane >> 3) + 8 * j; const LAS float* s = scr + (8 * c) * 33 + n;
        v4u o; o.x = pk2(s[0 * 33], s[1 * 33]); o.y = pk2(s[2 * 33], s[3 * 33]); o.z = pk2(s[4 * 33], s[5 * 33]); o.w = pk2(s[6 * 33], s[7 * 33]);
        *(v4u*)(WT + (size_t)(drow0 + n) * Kd + dk0 + 8 * c) = o; }
    LDS_WAIT();
}

template <bool DO_LN, bool DO_U> __device__ __forceinline__ void row_pass(const float* xin, float* xout, const float* lng, const float* lnb, const float* mod, int sh_off, int sc_off, bf16* U, int gw, int NGW, int lane) {
    for (int m = gw; m < M; m += NGW) {
        const int b = m >> 13;
        const f32x4* xr = (const f32x4*)(xin + (size_t)m * D) + lane;
        f32x4 v[4];
#pragma unroll
        for (int j = 0; j < 4; ++j) v[j] = xr[64 * j];
        if (DO_LN) {
            float s = 0.f;
#pragma unroll
            for (int j = 0; j < 4; ++j) s += (v[j].x + v[j].y) + (v[j].z + v[j].w);
            const float mean = wave_sum(s) * (1.f / D); float s2 = 0.f;
#pragma unroll
            for (int j = 0; j < 4; ++j) { v[j] = v[j] - mean; s2 += (v[j].x * v[j].x + v[j].y * v[j].y) + (v[j].z * v[j].z + v[j].w * v[j].w); }
            const float rstd = 1.f / sqrtf(wave_sum(s2) * (1.f / D) + LN_EPS);
            f32x4* xo = (f32x4*)(xout + (size_t)m * D) + lane;
#pragma unroll
            for (int j = 0; j < 4; ++j) { const f32x4 gg = *((const f32x4*)lng + lane + 64 * j), bb = *((const f32x4*)lnb + lane + 64 * j); v[j] = v[j] * rstd * gg + bb; xo[64 * j] = v[j]; }
        }
        if (DO_U) {
            const f32x4* shp = (const f32x4*)(mod + (size_t)b * NMOD + sh_off) + lane; const f32x4* scp = (const f32x4*)(mod + (size_t)b * NMOD + sc_off) + lane;
            unsigned long long* o8 = (unsigned long long*)(U + (size_t)m * D) + lane;
#pragma unroll
            for (int j = 0; j < 4; ++j) { const f32x4 u = v[j] * (scp[64 * j] + 1.0f) + shp[64 * j];
                o8[64 * j] = (unsigned long long)pk2(u.x, u.y) | ((unsigned long long)pk2(u.z, u.w) << 32); }
        }
    }
}

#define GAS __attribute__((address_space(1)))
#define XB_TMO      128
#define XB_XCNT(j)  (256  + 64 * (j))
#define XB_XSUB(j)  (1280 + 64 * (j))
#define XB_XGEN(j)  (2304 + 64 * (j))
#define XB_TOP      3328
#define XB_TOPGEN   3392
#define XCD_BAR_WORDS 3456
#define XB_SPIN_CAP (1u << 18)

__device__ __forceinline__ unsigned xb_ld(unsigned* p)              { return __hip_atomic_load(p, __ATOMIC_RELAXED, __HIP_MEMORY_SCOPE_AGENT); }
__device__ __forceinline__ unsigned xb_add(unsigned* p, unsigned v) { return __hip_atomic_fetch_add(p, v, __ATOMIC_RELAXED, __HIP_MEMORY_SCOPE_AGENT); }
__device__ __forceinline__ unsigned xb_xcc_id() { return (unsigned)__builtin_amdgcn_s_getreg((3 << 11) | 20) & 0xFu; }
#define XB_SPIN(cond, bar) do { unsigned _sp = 0; while (cond) { __builtin_amdgcn_s_sleep(1); \
    if ((++_sp & 255u) == 0u) { if (xb_ld(&(bar)[XB_TMO])) break; if (_sp > XB_SPIN_CAP) { atomicAdd(&(bar)[XB_TMO], 1u); break; } } } } while (0)

struct XcdBarrier {
    unsigned* bar; unsigned x;
    volatile LAS unsigned* st;
};

__device__ __forceinline__ XcdBarrier xcd_barrier_post(unsigned* bar, volatile LAS unsigned* st) {
    XcdBarrier b; b.bar = bar; b.x = xb_xcc_id(); b.st = st;
    if (threadIdx.x == 0) (void)xb_add(&bar[XB_XCNT(b.x)], 1u);
    return b;
}
__device__ __forceinline__ void xcd_barrier_complete(unsigned* bar, unsigned x, unsigned& nloc, unsigned& nx) {
    const unsigned G = gridDim.x * gridDim.y * gridDim.z;
    unsigned sum, cnt, mine, sp = 0u;
    for (;;) {
        sum = 0u; cnt = 0u; mine = 0u;
#pragma unroll
        for (unsigned j = 0; j < 16; ++j) { const unsigned c = xb_ld(&bar[XB_XCNT(j)]); sum += c; cnt += (c > 0u) ? 1u : 0u; mine = (j == x) ? c : mine; }
        if (sum == G) break;
        __builtin_amdgcn_s_sleep(1);
        if ((++sp & 255u) == 0u) { if (xb_ld(&bar[XB_TMO])) break; if (sp > XB_SPIN_CAP) { atomicAdd(&bar[XB_TMO], 1u); break; } }
    }
    nloc = mine > 0u ? mine : 1u; nx = cnt > 0u ? cnt : 1u;
}

__device__ __forceinline__ void xcd_barrier(const XcdBarrier& b) {
    asm volatile("s_waitcnt vmcnt(0)" ::: "memory");
    __syncthreads();
    if (threadIdx.x == 0) {
        unsigned* bar = b.bar;
        __builtin_amdgcn_s_waitcnt(0);
        unsigned nloc = b.st[0], nx = b.st[1];
        if (nloc == 0u) { xcd_barrier_complete(bar, b.x, nloc, nx); b.st[0] = nloc; b.st[1] = nx; }
        const unsigned old = xb_add(&bar[XB_XSUB(b.x)], 1u);
        const unsigned gen = old / nloc;
        if (old + 1u == (gen + 1u) * nloc) {
            __builtin_amdgcn_fence(__ATOMIC_RELEASE, "agent");
            asm volatile("s_waitcnt vmcnt(0)" ::: "memory");
            const unsigned og = xb_add(&bar[XB_TOP], 1u);
            const unsigned tg = og / nx;
            if (og + 1u == (tg + 1u) * nx) xb_add(&bar[XB_TOPGEN], 1u);
            else XB_SPIN(xb_ld(&bar[XB_TOPGEN]) == tg, bar);
            __builtin_amdgcn_fence(__ATOMIC_ACQUIRE, "agent");
            xb_add(&bar[XB_XGEN(b.x)], 1u);
            asm volatile("s_waitcnt vmcnt(0)" ::: "memory");
        } else {
            XB_SPIN(xb_ld(&bar[XB_XGEN(b.x)]) == gen, bar);
            __builtin_amdgcn_fence(__ATOMIC_ACQUIRE, "agent");
            asm volatile("s_waitcnt vmcnt(0)" ::: "memory");
        }
    }
    __syncthreads();
}

__global__ void __launch_bounds__(NTHREADS, 2) mega_fwd(Args a_unused) {
    extern __shared__ __attribute__((aligned(16))) unsigned char lds_raw[];
    cg::grid_group grid = cg::this_grid();
    (void)a_unused;
    { volatile LAS unsigned* misc = (volatile LAS unsigned*)((LAS unsigned char*)lds_raw + LDS_BYTES - 64);
      if (threadIdx.x < 16) misc[threadIdx.x] = 0u;
      __syncthreads();
      (void)xcd_barrier_post((unsigned*)((const Args*)__builtin_amdgcn_kernarg_segment_ptr())->ws + WS_CTL / 4, misc + 8); }
#define PH_BEGIN { const Args* ap = (const Args*)__builtin_amdgcn_kernarg_segment_ptr(); asm volatile("" : "+s"(ap)); unsigned char* ws; { const unsigned long long w_ = (unsigned long long)ap->ws; const unsigned lo_ = __builtin_amdgcn_readfirstlane((unsigned)w_), hi_ = __builtin_amdgcn_readfirstlane((unsigned)(w_ >> 32)); ws = (unsigned char*)(((unsigned long long)hi_ << 32) | lo_); } asm volatile("" : "+s"(ws)); \
    LAS unsigned char* lds = (LAS unsigned char*)lds_raw; const int tid = threadIdx.x, lane = tid & 63, wave = __builtin_amdgcn_readfirstlane(tid >> 6); \
    const int G = gridDim.x, bx = blockIdx.x, gw = bx * 8 + wave, NGW = G * 8; (void)lane; (void)gw; (void)NGW; (void)lds;
#define PH_END } { XcdBarrier b_; b_.bar = (unsigned*)((const Args*)__builtin_amdgcn_kernarg_segment_ptr())->ws + WS_CTL / 4; b_.x = xb_xcc_id(); b_.st = (volatile LAS unsigned*)((LAS unsigned char*)lds_raw + LDS_BYTES - 64) + 8; xcd_barrier(b_); }
#define mod ((float*)(ws + WS_MOD))
#define posb ((float*)(ws + WS_POSB))
#define CS8 ((float*)(ws + WS_CS8))
#define CS16 ((float*)(ws + WS_CS16))
#define Wgu1 ((bf16*)(ws + WS_WGU1))
#define Wd1 ((bf16*)(ws + WS_WD1))
#define Wgu2 ((bf16*)(ws + WS_WGU2))
#define Wd2 ((bf16*)(ws + WS_WD2))
#define Win ((bf16*)(ws + WS_WIN))
#define Wout ((bf16*)(ws + WS_WOUT))
#define Wuq ((bf16*)(ws + WS_WUQ))
#define Wukv ((bf16*)(ws + WS_WUKV))
#define W1k ((bf16*)(ws + WS_W1K))
#define W1v ((bf16*)(ws + WS_W1V))
#define KCMP ((bf16*)(ws + WS_KCMP))
#define VCMP ((bf16*)(ws + WS_VCMP))
#define YK ((float*)(ws + WS_YK))
#define YV ((float*)(ws + WS_YV))
#define GATES ((float*)(ws + WS_GATES))
#define KR ((bf16*)(ws + WS_KR))
#define U ((bf16*)(ws + WS_U))
#define HFF ((bf16*)(ws + WS_HFF))
#define H ((bf16*)(ws + WS_H))
#define QMLA ((bf16*)(ws + WS_QMLA))
#define KVMLA ((bf16*)(ws + WS_KVMLA))
#define QN ((bf16*)(ws + WS_QN))
#define KV6 ((bf16*)(ws + WS_KV6))
#define CQN ((bf16*)(ws + WS_CQN))
#define CKVN ((bf16*)(ws + WS_CKVN))
#define XIN (ap->in[0])
#define XOUT (ap->out)

    PH_BEGIN
    {
        LAS float* sc = (LAS float*)(lds + 131072);
        for (int i = tid; i < 2 * D; i += NTHREADS) { const float cv = ap->in[1][i]; sc[i] = cv / (1.f + expf(-cv)); }
        __syncthreads();
        LAS float* red = (LAS float*)lds;
        for (int cb = bx; cb < 256; cb += G) {
            const int col = tid % 36, kc = tid / 36, j = 36 * cb + col;
            if (kc < 14) {
                float a0 = 0.f, a1 = 0.f; const int k1 = (kc * 74 + 74 < D) ? kc * 74 + 74 : D;
                for (int k = kc * 74; k < k1; ++k) { const float w = ap->in[2][(size_t)k * NMOD + j]; a0 += sc[k] * w; a1 += sc[D + k] * w; }
                red[(kc * 36 + col) * 2] = a0; red[(kc * 36 + col) * 2 + 1] = a1;
            }
            __syncthreads();
            if (tid < 72) { const int c2 = tid >> 1, bb = tid & 1; float s = ap->in[3][36 * cb + c2];
                for (int q = 0; q < 14; ++q) s += red[(q * 36 + c2) * 2 + bb];
                mod[(size_t)bb * NMOD + 36 * cb + c2] = s; }
            __syncthreads();
        }
        for (int o = gw; o < 512; o += NGW) {
            const int which = o >> 8, j = o & 255; const float* pe = ap->in[which ? 13 : 10]; const float* w1 = ap->in[which ? 14 : 11];
            float s = 0.f;
            for (int k = lane; k < 2048; k += 64) s += pe[k] * w1[(size_t)k * 256 + j];
            s = wave_sum(s);
            if (lane == 0) posb[which * 256 + j] = s;
        }
        for (int e = bx * NTHREADS + tid; e < 8192 * 24; e += G * NTHREADS) {
            const int pos = e / 24, i = e % 24; double iv = 0.0;
#pragma unroll
            for (int q = 0; q < 8; ++q) if (i == q) iv = ap->inv8[q];
#pragma unroll
            for (int q = 0; q < 16; ++q) if (i == 8 + q) iv = ap->inv16[q];
            float c_, s_; rope_cs(pos, iv, c_, s_);
            if (i < 8) { CS8[pos * 16 + i] = c_; CS8[pos * 16 + 8 + i] = s_; } else { CS16[pos * 32 + (i - 8)] = c_; CS16[pos * 32 + 16 + (i - 8)] = s_; }
        }
        __syncthreads();
        LAS float* scr = (LAS float*)(lds + wave * 16384);
        constexpr int I_GU = (D / 64) * (FF / 32), I_WD = (FF / 64) * (D / 32), I_IN = (D / 64) * (DINP / 32), I_W1 = (2048 / 64) * (256 / 32), I_UQ = (384 / 64) * (768 / 32),
                      I_UKV = (256 / 64) * (1024 / 32), I_OUT = (D / 64) * (D / 32);
        constexpr int NITEMS = 4 * I_GU + 2 * I_WD + I_IN + 2 * I_W1 + I_UQ + I_UKV + I_OUT;
        for (int it = gw; it < NITEMS; it += NGW) {
            int r = it;
#define TR_TRY(CNT, NBLK, ...) if (r < (CNT)) { const int k0 = 64 * (r / (NBLK)), n0 = 32 * (r % (NBLK)); (void)k0; (void)n0; __VA_ARGS__; continue; } r -= (CNT);
            TR_TRY(I_GU, FF / 32, tr_item(ap->in[6], FF, k0, n0, Wgu1, D, (n0 / 128) * 256 + (n0 % 128), k0, scr, lane))
            TR_TRY(I_GU, FF / 32, tr_item(ap->in[7], FF, k0, n0, Wgu1, D, (n0 / 128) * 256 + 128 + (n0 % 128), k0, scr, lane))
            TR_TRY(I_WD, D / 32, tr_item(ap->in[8], D, k0, n0, Wd1, FF, n0, k0, scr, lane))
            TR_TRY(I_GU, FF / 32, tr_item(ap->in[21], FF, k0, n0, Wgu2, D, (n0 / 128) * 256 + (n0 % 128), k0, scr, lane))
            TR_TRY(I_GU, FF / 32, tr_item(ap->in[22], FF, k0, n0, Wgu2, D, (n0 / 128) * 256 + 128 + (n0 % 128), k0, scr, lane))
            TR_TRY(I_WD, D / 32, tr_item(ap->in[23], D, k0, n0, Wd2, FF, n0, k0, scr, lane))
            TR_TRY(I_IN, DINP / 32, tr_item(ap->in[9], DIN, k0, n0, Win, D, n0, k0, scr, lane))
            TR_TRY(I_W1, 256 / 32, tr_item(ap->in[11], 256, k0, n0, W1k, 1024, (k0 >= 1024 ? 256 : 0) + n0, k0 & 1023, scr, lane))
            TR_TRY(I_W1, 256 / 32, tr_item(ap->in[14], 256, k0, n0, W1v, 1024, (k0 >= 1024 ? 256 : 0) + n0, k0 & 1023, scr, lane))
            TR_TRY(I_UQ, 768 / 32, { const int hq = n0 / 96, jq = (n0 % 96) / 32; tr_item(ap->in[18], 768, k0, n0, Wuq, 384, jq < 2 ? hq * 64 + 32 * jq : 512 + hq * 32, k0, scr, lane); })
            TR_TRY(I_UKV, 1024 / 32, { const int hk = n0 / 128, ek = n0 % 128; tr_item(ap->in[19], 1024, k0, n0, Wukv, 256, ek < 64 ? hk * 64 + ek : 512 + hk * 64 + (ek - 64), k0, scr, lane); })
            TR_TRY(I_OUT, D / 32, tr_item(ap->in[20], D, k0, n0, Wout, D, n0, k0, scr, lane))
#undef TR_TRY
        }
    }
    } grid.sync();

    PH_BEGIN
    row_pass<false, true>(XIN, nullptr, nullptr, nullptr, mod, 0 * D, 1 * D, U, gw, NGW, lane);
    PH_END

    PH_BEGIN
#if !defined(ONLY_G) || ONLY_G == 1
    { int Kq = D; asm volatile("" : "+s"(Kq)); pg8::Gemm g{U, Wgu1, M, 2 * FF, Kq}; pg8::StaticOrder S; S.init(M, 2 * FF, G, bx); pg8::EpiSwiglu E{HFF, FF};
      pg8::gemm_phase<pg8::EpiSwiglu, pg8::StaticOrder, true, true>(lds, g, S, E); }
#endif
    PH_END
    PH_BEGIN
#if !defined(ONLY_G) || ONLY_G == 2
    { int Kq = FF; asm volatile("" : "+s"(Kq)); pg8::Gemm g{HFF, Wd1, M, D, Kq}; pg8::StaticOrder S; S.init(M, D, G, bx); pg8::EpiResid E{XIN, XOUT, mod + 2 * D, 0.5f};
      pg8::gemm_phase<pg8::EpiResid, pg8::StaticOrder, true, true>(lds, g, S, E); }
#endif
    PH_END
    PH_BEGIN
    row_pass<true, true>(XOUT, XOUT, ap->in[4] + 0 * D, ap->in[5] + 0 * D, mod, 3 * D, 4 * D, U, gw, NGW, lane);
    PH_END
    PH_BEGIN
#if !defined(ONLY_G) || ONLY_G == 3
    { int Kq = D; asm volatile("" : "+s"(Kq)); pg8::Gemm g{U, Win, M, DINP, Kq}; pg8::StaticOrder S; S.init(M, DINP, G, bx); pg8::EpiBf16<0> E{H, DINP, nullptr, 0, 0, 1.f};
      pg8::gemm_phase<pg8::EpiBf16<0>, pg8::StaticOrder, true, true>(lds, g, S, E); }
#endif
    PH_END
    PH_BEGIN
    {
        LAS v4u* rb = (LAS v4u*)(lds + wave * 4096); LAS unsigned short* hb = (LAS unsigned short*)rb;
        for (int m = gw; m < M; m += NGW) {
            const int b = m >> 13, t = m & 8191;
            const v4u* hr = (const v4u*)(H + (size_t)m * DINP);
#pragma unroll
            for (int j = 0; j < 4; ++j) rb[lane + 64 * j] = hr[lane + 64 * j];
            LDS_WAIT();
            {
                const int base = 8 * lane, d0 = 8 * (lane & 7); float v[8];
#pragma unroll
                for (int e = 0; e < 8; ++e) v[e] = bf2f(hb[base + e]);
                if (d0 < 16) {
#pragma unroll
                    for (int e = 0; e < 8; ++e) { const float c_ = CS8[t * 16 + e], s_ = CS8[t * 16 + 8 + e]; const float pr = bf2f(hb[base + e + (d0 == 0 ? 8 : -8)]); v[e] = (d0 == 0) ? v[e] * c_ - pr * s_ : v[e] * c_ + pr * s_; }
                }
                v4u o; o.x = pk2(v[0] * QS_NSA, v[1] * QS_NSA); o.y = pk2(v[2] * QS_NSA, v[3] * QS_NSA); o.z = pk2(v[4] * QS_NSA, v[5] * QS_NSA); o.w = pk2(v[6] * QS_NSA, v[7] * QS_NSA);
                *(v4u*)(QN + (size_t)m * 512 + base) = o;
            }
#pragma unroll
            for (int it = 0; it < 2; ++it) {
                const int ch = lane + 64 * it;
                if (ch < 96) {
                    const int seg = ch >> 4, w = ch & 15, g = w >> 3, d0 = 8 * (w & 7), base = 512 + 128 * seg + 64 * g + d0; float v[8];
#pragma unroll
                    for (int e = 0; e < 8; ++e) v[e] = bf2f(hb[base + e]);
                    if ((seg & 1) == 0 && d0 < 16) {
#pragma unroll
                        for (int e = 0; e < 8; ++e) { const float c_ = CS8[t * 16 + e], s_ = CS8[t * 16 + 8 + e]; const float pr = bf2f(hb[base + e + (d0 == 0 ? 8 : -8)]); v[e] = (d0 == 0) ? v[e] * c_ - pr * s_ : v[e] * c_ + pr * s_; }
                    }
                    v4u o; o.x = pk2(v[0], v[1]); o.y = pk2(v[2], v[3]); o.z = pk2(v[4], v[5]); o.w = pk2(v[6], v[7]);
                    *(v4u*)(KV6 + (size_t)seg * KV6_SEG + ((size_t)(b * 2 + g) * T + t) * 64 + d0) = o;
                }
            }
            if (lane < 24) GATES[(size_t)m * 24 + lane] = 1.f / (1.f + expf(-bf2f(hb[1280 + lane])));
            {
                float xv[6]; float ss = 0.f;
#pragma unroll
                for (int j = 0; j < 3; ++j) { xv[2 * j] = bf2f(hb[1304 + 2 * lane + 128 * j]); xv[2 * j + 1] = bf2f(hb[1304 + 2 * lane + 128 * j + 1]); ss += xv[2 * j] * xv[2 * j] + xv[2 * j + 1] * xv[2 * j + 1]; }
                const float r = 1.f / sqrtf(wave_sum(ss) * (1.f / 384.f) + LN_EPS);
#pragma unroll
                for (int j = 0; j < 3; ++j) { const int i = 2 * lane + 128 * j; *(unsigned*)(CQN + (size_t)m * 384 + i) = pk2(xv[2 * j] * r * ap->in[16][i], xv[2 * j + 1] * r * ap->in[16][i + 1]); }
            }
            {
                float xv[4]; float ss = 0.f;
#pragma unroll
                for (int j = 0; j < 2; ++j) { xv[2 * j] = bf2f(hb[1688 + 2 * lane + 128 * j]); xv[2 * j + 1] = bf2f(hb[1688 + 2 * lane + 128 * j + 1]); ss += xv[2 * j] * xv[2 * j] + xv[2 * j + 1] * xv[2 * j + 1]; }
                const float r = 1.f / sqrtf(wave_sum(ss) * (1.f / 256.f) + LN_EPS);
#pragma unroll
                for (int j = 0; j < 2; ++j) { const int i = 2 * lane + 128 * j; *(unsigned*)(CKVN + (size_t)m * 256 + i) = pk2(xv[2 * j] * r * ap->in[17][i], xv[2 * j + 1] * r * ap->in[17][i + 1]); }
            }
            if (lane < 32) {
                const float xs = bf2f(hb[1944 + lane]), pr = bf2f(hb[1944 + (lane ^ 16)]); const float c_ = CS16[t * 32 + (lane & 15)], s_ = CS16[t * 32 + 16 + (lane & 15)];
                const float r = (lane < 16) ? xs * c_ - pr * s_ : xs * c_ + pr * s_;
                KR[(size_t)m * 32 + lane] = (bf16)f2bf(r);
            }
            LDS_WAIT(); asm volatile("" ::: "memory");
        }
    }
    PH_END
    PH_BEGIN
#if !defined(ONLY_G) || ONLY_G == 4
    { int Kq = 384; asm volatile("" : "+s"(Kq)); pg8::Gemm g{CQN, Wuq, M, 768, Kq}; pg8::StaticOrder S; S.init(M, 768, G, bx); pg8::EpiQmla E{QMLA, CS16};
      pg8::gemm_phase<pg8::EpiQmla, pg8::StaticOrder, true, true>(lds, g, S, E); }
#endif
#if !defined(ONLY_G) || ONLY_G == 5
    { int Kq = 1024; asm volatile("" : "+s"(Kq)); pg8::Gemm g{KV6 + 0 * KV6_SEG, W1k, 2048, 512, Kq}; pg8::StaticOrder S; S.init(2048, 512, G, (bx + G - 192 % G) % G); pg8::EpiF32 E{YK, 512};
      pg8::gemm_phase<pg8::EpiF32, pg8::StaticOrder, true, true>(lds, g, S, E); }
#endif
#if !defined(ONLY_G) || ONLY_G == 6
    { int Kq = 1024; asm volatile("" : "+s"(Kq)); pg8::Gemm g{KV6 + 1 * KV6_SEG, W1v, 2048, 512, Kq}; pg8::StaticOrder S; S.init(2048, 512, G, (bx + G - 208 % G) % G); pg8::EpiF32 E{YV, 512};
      pg8::gemm_phase<pg8::EpiF32, pg8::StaticOrder, true, true>(lds, g, S, E); }
#endif
#if !defined(ONLY_G) || ONLY_G == 7
    { int Kq = 256; asm volatile("" : "+s"(Kq)); pg8::Gemm g{CKVN, Wukv, M, 1024, Kq}; pg8::StaticOrder S; S.init(M, 1024, G, bx); pg8::EpiBf16<0> E{KVMLA, 1024, nullptr, 0, 0, 1.f};
      pg8::gemm_phase<pg8::EpiBf16<0>, pg8::StaticOrder, true, true>(lds, g, S, E); }
#endif
    PH_END
    PH_BEGIN
    {
        LAS float* hbuf = (LAS float*)(lds + wave * 1024);
        for (int idx = gw; idx < 2 * 4 * 512; idx += NGW) {
            const int kv = idx >> 11, bg = (idx >> 9) & 3, n = idx & 511;
            bf16* dst = (kv ? VCMP : KCMP) + ((size_t)bg * 512 + n) * 64;
            if (n == 511) { dst[lane] = 0; continue; }
            const float* Y = kv ? YV : YK; const float* pb = posb + kv * 256; const float* w2 = ap->in[kv ? 15 : 12];
#pragma unroll
            for (int i = 0; i < 4; ++i) { const int j = lane + 64 * i; const float p = Y[((size_t)bg * 512 + n) * 512 + j] + Y[((size_t)bg * 512 + n + 1) * 512 + 256 + j] + pb[j];
                const float y = 0.7978845608028654f * (p + 0.044715f * p * p * p); const float th = 1.f - 2.f / (expf(2.f * y) + 1.f); hbuf[j] = 0.5f * p * (1.f + th); }
            LDS_WAIT();
            float acc = 0.f;
#pragma unroll 8
            for (int j = 0; j < 256; ++j) acc += hbuf[j] * w2[j * 64 + lane];
            dst[lane] = (bf16)f2bf(acc);
            LDS_WAIT(); asm volatile("" ::: "memory");
        }
    }
    PH_END
    PH_BEGIN
    {
#ifndef NO_ATT
        for (int pi = bx; pi < 256; pi += G) {
#ifndef REP_MLA
#define REP_MLA 1
#endif
#ifndef REP_NSA
#define REP_NSA 1
#endif
#pragma nounroll
            for (int rep = 0; rep < 2 * REP_MLA; ++rep) {
                unsigned char* w2 = ws; asm volatile("" : "+s"(w2));
                const att::MlaPtrs MP{(const bf16*)(w2 + WS_QMLA), (const bf16*)(w2 + WS_KVMLA), (const bf16*)(w2 + WS_KR), (bf16*)(w2 + WS_U)};
                const int bh = pi >> 4, s = pi & 15; att::mla_item(lds, MP, bh >> 3, bh & 7, (rep & 1) ? s : 31 - s, tid);
            }
#ifndef NO_NSA
#pragma nounroll
            for (int rep = 0; rep < 2 * REP_NSA; ++rep) {
                unsigned char* w2 = ws; asm volatile("" : "+s"(w2));
                const att::NsaPtrs NP{(const bf16*)(w2 + WS_QN), (const bf16*)(w2 + WS_KV6), (const bf16*)(w2 + WS_KCMP), (const bf16*)(w2 + WS_VCMP), (const float*)(w2 + WS_GATES), (bf16*)(w2 + WS_U)};
                const int bg = pi >> 6, s = pi & 63; att::nsa_item(lds, NP, bg >> 1, bg & 1, (rep & 1) ? s : 127 - s, tid);
            }
#endif
        }
#endif
    }
    PH_END
    PH_BEGIN
#if !defined(ONLY_G) || ONLY_G == 8
    { int Kq = D; asm volatile("" : "+s"(Kq)); pg8::Gemm g{U, Wout, M, D, Kq}; pg8::StaticOrder S; S.init(M, D, G, bx); pg8::EpiResid E{XOUT, XOUT, mod + 5 * D, 1.0f};
      pg8::gemm_phase<pg8::EpiResid, pg8::StaticOrder, true, true>(lds, g, S, E); }
#endif
    PH_END
    PH_BEGIN
    row_pass<true, true>(XOUT, XOUT, ap->in[4] + 1 * D, ap->in[5] + 1 * D, mod, 6 * D, 7 * D, U, gw, NGW, lane);
    PH_END
    PH_BEGIN
#if !defined(ONLY_G) || ONLY_G == 9
    { int Kq = D; asm volatile("" : "+s"(Kq)); pg8::Gemm g{U, Wgu2, M, 2 * FF, Kq}; pg8::StaticOrder S; S.init(M, 2 * FF, G, bx); pg8::EpiSwiglu E{HFF, FF};
      pg8::gemm_phase<pg8::EpiSwiglu, pg8::StaticOrder, true, true>(lds, g, S, E); }
#endif
    PH_END
    PH_BEGIN
#if !defined(ONLY_G) || ONLY_G == 10
    { int Kq = FF; asm volatile("" : "+s"(Kq)); pg8::Gemm g{HFF, Wd2, M, D, Kq}; pg8::StaticOrder S; S.init(M, D, G, bx); pg8::EpiResid E{XOUT, XOUT, mod + 8 * D, 0.5f};
      pg8::gemm_phase<pg8::EpiResid, pg8::StaticOrder, true, true>(lds, g, S, E); }
#endif
    PH_END
#ifdef REP_SYNC
    for (int r_ = 0; r_ < REP_SYNC; ++r_) { PH_BEGIN PH_END }
#endif
    PH_BEGIN
    row_pass<true, false>(XOUT, XOUT, ap->in[4] + 2 * D, ap->in[5] + 2 * D, mod, 0, 0, U, gw, NGW, lane);
    }
}

#undef PH_BEGIN
#undef PH_END
#undef mod
#undef posb
#undef CS8
#undef CS16
#undef Wgu1
#undef Wd1
#undef Wgu2
#undef Wd2
#undef Win
#undef Wout
#undef Wuq
#undef Wukv
#undef W1k
#undef W1v
#undef KCMP
#undef VCMP
#undef YK
#undef YV
#undef GATES
#undef KR
#undef U
#undef HFF
#undef H
#undef QMLA
#undef KVMLA
#undef QN
#undef KV6
#undef CQN
#undef CKVN
#undef XIN
#undef XOUT

extern "C" void kernel_launch(void* const* d_in, const int* in_sizes, int n_in, void* d_out, int out_size, void* d_ws, size_t ws_size, hipStream_t stream) {
    static int grid = 0;
    if (grid == 0) {
        if (n_in != 24 || ws_size < WS_END) { fprintf(stderr, "kernel_launch: unexpected inputs (n_in %d, ws %zu)\n", n_in, ws_size); grid = -1; return; }
        int dev = 0, cus = 0, per_cu = 0;
        (void)hipGetDevice(&dev); (void)hipDeviceGetAttribute(&cus, hipDeviceAttributeMultiprocessorCount, dev);
        (void)hipFuncSetAttribute((const void*)mega_fwd, hipFuncAttributeMaxDynamicSharedMemorySize, LDS_BYTES);
        if (hipOccupancyMaxActiveBlocksPerMultiprocessor(&per_cu, (const void*)mega_fwd, NTHREADS, LDS_BYTES) != hipSuccess || per_cu < 1) { fprintf(stderr, "kernel_launch: occupancy query says %d\n", per_cu); per_cu = 1; }
        (void)hipGetLastError();
        grid = cus * per_cu;
    }
    if (grid < 0) return;
    Args a{};
    for (int i = 0; i < 24; ++i) a.in[i] = (const float*)d_in[i];
    a.out = (float*)d_out; a.ws = (unsigned char*)d_ws;
    const double two_pi = 6.283185307179586476925286766559;
    for (int i = 0; i < 8; ++i) a.inv8[i] = pow(500000.0, -(double)i / 8.0) / two_pi;
    for (int i = 0; i < 16; ++i) a.inv16[i] = pow(500000.0, -(double)i / 16.0) / two_pi;
    if (hipMemsetAsync((unsigned char*)d_ws + WS_CTL, 0, CTL_BYTES, stream) != hipSuccess) { fprintf(stderr, "kernel_launch: memset failed\n"); return; }
    void* args[] = {&a};
    hipError_t e = hipLaunchCooperativeKernel((const void*)mega_fwd, dim3(grid), dim3(NTHREADS), args, LDS_BYTES, stream);
    if (e != hipSuccess) fprintf(stderr, "cooperative launch failed: %s (grid %d)\n", hipGetErrorString(e), grid);
}
```

```cpp
#include <hip/hip_runtime.h>
#include <hip/hip_cooperative_groups.h>
#include <cstdio>
#include <cstdint>
#include <cmath>
namespace cg = cooperative_groups;
namespace pg8 {
#define PG8_LAS __attribute__((address_space(3)))
typedef unsigned short bf16_t;
typedef short bf16x8 __attribute__((ext_vector_type(8)));
typedef float f32x4 __attribute__((ext_vector_type(4)));
typedef unsigned u32x4 __attribute__((ext_vector_type(4)));
constexpr int BM = 256, BK = 64, HALF = 128, HTB = HALF * BK * 2  , STAGE_BYTES = 8 * HTB, NXCD = 8, WGM = 8;

__host__ __device__ __forceinline__ int lds_byte(int r, int c) { const int st = (r >> 4) * 2 + (c >> 5), rr = r & 15, cc = c & 31, ob = rr * 64 + cc * 2; return st * 1024 + (ob ^ (((ob >> 9) & 1) << 5)); }
__host__ __device__ __forceinline__ void stage_rc(int b, int& R, int& C) { const int st = b / 1024, sb = b % 1024, swz = sb ^ (((sb >> 9) & 1) << 5); R = (st >> 1) * 16 + swz / 64; C = (st & 1) * 32 + (swz % 64) / 2; }
__host__ __device__ __forceinline__ int perm32(int rho) { const int n = rho >> 4, i = rho & 15; return 8 * (i >> 2) + 4 * n + (i & 3); }

struct Unit { int pm, pn; };
struct Gemm { const bf16_t* A; const bf16_t* Bt; int M, N, K; };

struct StaticOrder {
    int nM, nN, nwg, G, c;
    __host__ __device__ void init(int M, int N, int G_, int c_) { nM = M / BM; nN = N / BM; nwg = nM * nN; G = G_; c = c_; }
    __host__ __device__ bool next(int i, Unit& u) const {
        const long L = (long)i * G + c; if (L >= nwg) return false;
        int wgid = (int)L; { const int q = nwg / NXCD, r = nwg % NXCD, xcd = wgid % NXCD, off = wgid / NXCD; wgid = (xcd < r ? xcd * (q + 1) : r * (q + 1) + (xcd - r) * q) + off; }
        const int nig = WGM * nN, gid = wgid / nig, fm = gid * WGM, gsz = (nM - fm) < WGM ? (nM - fm) : WGM;
        u.pm = fm + ((wgid % nig) % gsz); u.pn = (wgid % nig) / gsz; return true;
    }
    __device__ __forceinline__ void a_ready(const Unit&) const {}
    __device__ __forceinline__ void done(const Unit&) const {}
};

__device__ __forceinline__ unsigned cvt_pk_bf16(float lo, float hi) { unsigned r; asm volatile("v_cvt_pk_bf16_f32 %0, %1, %2" : "=v"(r) : "v"(lo), "v"(hi)); return r; }
typedef float f32x2 __attribute__((ext_vector_type(2)));
__device__ __forceinline__ f32x2 gelu_pk(f32x2 v) {
    const f32x2 av = __builtin_elementwise_abs(v), d = av * 0.2316418882f + 1.0f;
    f32x2 t; t.x = __builtin_amdgcn_rcpf(d.x); t.y = __builtin_amdgcn_rcpf(d.y);
    f32x2 q = t * 0.5307027145f + (-0.7265760135f); q = q * t + 0.7107068705f; q = q * t + (-0.142248368f); q = q * t + 0.127414796f; q = q * t;
    const f32x2 s = (v * v) * (-0.72134752044f);
    f32x2 e; e.x = __builtin_amdgcn_exp2f(s.x); e.y = __builtin_amdgcn_exp2f(s.y);
    const f32x2 m = v * (q * e), r = v - m;
    f32x2 o; o.x = v.x < 0.f ? m.x : r.x; o.y = v.y < 0.f ? m.y : r.y; return o;
}

template <int ACT  > struct EpiBf16 {
    static constexpr bool PERM = true, AFTER_DRAIN = false; static_assert(ACT == 0 || ACT == 1, "EpiBf16: ACT is 0 (none) or 1 (gelu_pk)");
    bf16_t* O; int ldc; const float* bias; int split_cols; size_t split_stride; float scale0;
    __device__ __forceinline__ void operator()(const f32x4 (&acc)[2][2][4][2], const Unit& u, int wr, int wc, int fr, int fq) const {
        const int row0 = u.pm * BM + wr * 64 + fr; int colt = u.pn * BM; bf16_t* base = O;
        float sc = 1.f; if (split_cols) { const int t = colt / split_cols; base += (size_t)t * split_stride; colt -= t * split_cols; if (t == 0) sc = scale0; }
        const int col0 = colt + wc * 32 + 8 * fq, bcol0 = u.pn * BM + wc * 32 + 8 * fq;
        f32x4 bv[2][2];
#pragma unroll
        for (int bj = 0; bj < 2; ++bj)
#pragma unroll
            for (int n = 0; n < 2; ++n) bv[bj][n] = bias ? *(const f32x4*)(bias + bcol0 + bj * HALF + 4 * n) : (f32x4){0.f, 0.f, 0.f, 0.f};
#pragma unroll
        for (int ai = 0; ai < 2; ++ai)
#pragma unroll
            for (int m = 0; m < 4; ++m) { bf16_t* rowp = base + (size_t)(row0 + ai * HALF + m * 16) * ldc + col0;
#pragma unroll
                for (int bj = 0; bj < 2; ++bj) { f32x4 v0 = acc[ai][bj][m][0] + bv[bj][0], v1 = acc[ai][bj][m][1] + bv[bj][1];
                    if (ACT == 1) { f32x2 a = gelu_pk((f32x2){v0[0], v0[1]}), b = gelu_pk((f32x2){v0[2], v0[3]}), c = gelu_pk((f32x2){v1[0], v1[1]}), d = gelu_pk((f32x2){v1[2], v1[3]});
                        v0 = (f32x4){a.x, a.y, b.x, b.y}; v1 = (f32x4){c.x, c.y, d.x, d.y}; }
                    v0 = v0 * sc; v1 = v1 * sc; u32x4 w; w.x = cvt_pk_bf16(v0[0], v0[1]); w.y = cvt_pk_bf16(v0[2], v0[3]); w.z = cvt_pk_bf16(v1[0], v1[1]); w.w = cvt_pk_bf16(v1[2], v1[3]);
                    *(u32x4*)(rowp + bj * HALF) = w; } }
    }
};
template <class Epi, class Sched, bool ALIGN_EPI = false, bool SP2 = false>
__device__ __forceinline__ void gemm_phase(PG8_LAS unsigned char* lds, const Gemm g, const Sched& S, const Epi& E) {
    const int tid = threadIdx.x, wid = __builtin_amdgcn_readfirstlane(tid >> 6), lane = tid & 63, wr = wid >> 2, wc = wid & 3, fr = lane & 15, fq = lane >> 4;
    const int K = g.K, nt = K / BK;
    unsigned voffA[2], voffB[2];
#pragma unroll
    for (int i = 0; i < 2; ++i) { int R, C; stage_rc(tid * 16 + i * 8192, R, C); const int Rb = Epi::PERM ? ((R & ~31) + perm32(R & 31)) : R;
        voffA[i] = (unsigned)(R * K + C) * 2u; voffB[i] = (unsigned)(Rb * K + C) * 2u; }
    const size_t kstep = (size_t)(BK * 2);
    const size_t hstep = (size_t)HALF * K * 2;
    const size_t tstep = 2 * hstep;
    const unsigned ldsw = (unsigned)wid * 1024u;
    const int aoff = lds_byte(wr * 64 + fr, fq * 8), boff = lds_byte(wc * 32 + fr, fq * 8);
#define PG8_SA(b, h) (((b) * 2 + (h)) * HTB)
#define PG8_SB(b, h) ((4 + (b) * 2 + (h)) * HTB)
#define PG8_STAGE(bufoff, gbase, voff) do { _Pragma("unroll") for (int _i = 0; _i < 2; ++_i) \
        __builtin_amdgcn_global_load_lds((const unsigned*)((const char*)(gbase) + (voff)[_i]), (PG8_LAS unsigned*)(lds + (bufoff) + ldsw + _i * 8192), 16, 0, 0); } while (0)
#define PG8_LDA(dst, b, h) do { _Pragma("unroll") for (int m = 0; m < 4; ++m) _Pragma("unroll") for (int k = 0; k < 2; ++k) dst[m][k] = *(const PG8_LAS bf16x8*)(lds + PG8_SA(b, h) + aoff + m * 2048 + k * 1024); } while (0)
#define PG8_LDB(dst, b, h) do { _Pragma("unroll") for (int n = 0; n < 2; ++n) _Pragma("unroll") for (int k = 0; k < 2; ++k) dst[n][k] = *(const PG8_LAS bf16x8*)(lds + PG8_SB(b, h) + boff + n * 2048 + k * 1024); } while (0)
#define PG8_MMA(ai, bj, At, Bt) do { __builtin_amdgcn_s_setprio(1); _Pragma("unroll") for (int m = 0; m < 4; ++m) _Pragma("unroll") for (int n = 0; n < 2; ++n) _Pragma("unroll") for (int k = 0; k < 2; ++k) \
        acc[ai][bj][m][n] = __builtin_amdgcn_mfma_f32_16x16x32_bf16(Bt[n][k], At[m][k], acc[ai][bj][m][n], 0, 0, 0); __builtin_amdgcn_s_setprio(0); } while (0)
#define PG8_WAIT_V(n) asm volatile("s_waitcnt vmcnt(" #n ")" ::: "memory")
#define PG8_WAIT_L(n) asm volatile("s_waitcnt lgkmcnt(" #n ")" ::: "memory")
#define PG8_BAR __builtin_amdgcn_s_barrier()
#define PG8_SCHED __builtin_amdgcn_sched_barrier(0)
    Unit cur, nxt; int ui = 0;
    if (!S.next(0, cur)) return;
    f32x4 acc[2][2][4][2];
#pragma unroll
    for (int a = 0; a < 2; ++a)
#pragma unroll
        for (int b = 0; b < 2; ++b)
#pragma unroll
            for (int m = 0; m < 4; ++m)
#pragma unroll
                for (int n = 0; n < 2; ++n) acc[a][b][m][n] = (f32x4){0.f, 0.f, 0.f, 0.f};
    bf16x8 At[4][2], B0[2][2], B1[2][2];
    const char* cA = (const char*)g.A + (size_t)cur.pm * tstep; const char* cB = (const char*)g.Bt + (size_t)cur.pn * tstep;
    S.a_ready(cur);
    if constexpr (SP2) {
        PG8_STAGE(PG8_SB(0, 0), cB, voffB); PG8_STAGE(PG8_SB(0, 1), cB + hstep, voffB); PG8_STAGE(PG8_SA(0, 0), cA, voffA); PG8_STAGE(PG8_SA(0, 1), cA + hstep, voffA);
        if (wr == 1) PG8_BAR;
        PG8_WAIT_V(2); PG8_BAR;
        PG8_STAGE(PG8_SB(1, 0), cB + kstep, voffB); PG8_STAGE(PG8_SA(1, 0), cA + kstep, voffA); PG8_STAGE(PG8_SB(1, 1), cB + hstep + kstep, voffB);
        PG8_WAIT_V(6); PG8_BAR;
    } else {
        PG8_STAGE(PG8_SB(0, 0), cB, voffB); PG8_STAGE(PG8_SA(0, 0), cA, voffA); PG8_STAGE(PG8_SB(0, 1), cB + hstep, voffB); PG8_STAGE(PG8_SA(0, 1), cA + hstep, voffA);
        if (wr == 1) PG8_BAR;
        PG8_WAIT_V(4); PG8_BAR;
        PG8_STAGE(PG8_SB(1, 0), cB + kstep, voffB); PG8_STAGE(PG8_SA(1, 0), cA + kstep, voffA); PG8_STAGE(PG8_SB(1, 1), cB + hstep + kstep, voffB);
        PG8_WAIT_V(6); PG8_BAR;
    }
    for (;;) {
        const bool has_next = S.next(ui + 1, nxt);
        const char* nA = has_next ? (const char*)g.A + (size_t)nxt.pm * tstep : cA; const char* nB = has_next ? (const char*)g.Bt + (size_t)nxt.pn * tstep : cB;
        for (int t = 0; t < nt; t += 2) {
            const bool last = (t == nt - 2);
            const char* a1 = cA + (size_t)(t + 1) * kstep;
            const char* a2 = last ? nA : cA + (size_t)(t + 2) * kstep; const char* b2 = last ? nB : cB + (size_t)(t + 2) * kstep;
            const char* a3 = a2 + kstep; const char* b3 = b2 + kstep;
            if (last && has_next) S.a_ready(nxt);
            if constexpr (SP2) {
            PG8_LDB(B0, 0, 0); PG8_LDB(B1, 0, 1); PG8_SCHED; PG8_LDA(At, 0, 0); PG8_STAGE(PG8_SA(1, 1), a1 + hstep, voffA);
            PG8_WAIT_V(8); PG8_WAIT_L(0); PG8_BAR; PG8_MMA(0, 0, At, B0); PG8_MMA(0, 1, At, B1); PG8_BAR; PG8_SCHED;
            PG8_LDA(At, 0, 1); PG8_STAGE(PG8_SB(0, 0), b2, voffB); PG8_STAGE(PG8_SB(0, 1), b2 + hstep, voffB); PG8_STAGE(PG8_SA(0, 0), a2, voffA);
            PG8_WAIT_V(8); PG8_WAIT_L(0); PG8_BAR; PG8_MMA(1, 0, At, B0); PG8_MMA(1, 1, At, B1); PG8_BAR; PG8_SCHED;
            PG8_LDB(B0, 1, 0); PG8_LDB(B1, 1, 1); PG8_SCHED; PG8_LDA(At, 1, 0); PG8_STAGE(PG8_SA(0, 1), a2 + hstep, voffA);
            PG8_WAIT_V(8); PG8_WAIT_L(0); PG8_BAR; PG8_MMA(0, 0, At, B0); PG8_MMA(0, 1, At, B1); PG8_BAR; PG8_SCHED;
            PG8_LDA(At, 1, 1); PG8_STAGE(PG8_SB(1, 0), b3, voffB); PG8_STAGE(PG8_SB(1, 1), b3 + hstep, voffB); PG8_STAGE(PG8_SA(1, 0), a3, voffA);
            PG8_WAIT_V(8); PG8_WAIT_L(0); PG8_BAR; PG8_MMA(1, 0, At, B0); PG8_MMA(1, 1, At, B1); PG8_BAR; PG8_SCHED;
            } else {
            PG8_LDB(B0, 0, 0); PG8_SCHED; PG8_LDA(At, 0, 0); PG8_STAGE(PG8_SA(1, 1), a1 + hstep, voffA);
            PG8_WAIT_L(8); PG8_BAR; PG8_WAIT_L(0); PG8_MMA(0, 0, At, B0); PG8_BAR; PG8_SCHED;
            PG8_LDB(B1, 0, 1); PG8_STAGE(PG8_SB(0, 0), b2, voffB);
            PG8_BAR; PG8_WAIT_L(0); PG8_MMA(0, 1, At, B1); PG8_BAR;
            PG8_LDA(At, 0, 1); PG8_STAGE(PG8_SA(0, 0), a2, voffA);
            PG8_BAR; PG8_WAIT_L(0); PG8_MMA(1, 0, At, B0); PG8_BAR; PG8_SCHED;
            PG8_STAGE(PG8_SB(0, 1), b2 + hstep, voffB);
            PG8_WAIT_V(6); PG8_BAR; PG8_MMA(1, 1, At, B1); PG8_BAR;
            PG8_LDB(B0, 1, 0); PG8_SCHED; PG8_LDA(At, 1, 0); PG8_STAGE(PG8_SA(0, 1), a2 + hstep, voffA);
            PG8_WAIT_L(8); PG8_BAR; PG8_WAIT_L(0); PG8_MMA(0, 0, At, B0); PG8_BAR; PG8_SCHED;
            PG8_LDB(B1, 1, 1); PG8_STAGE(PG8_SB(1, 0), b3, voffB);
            PG8_BAR; PG8_WAIT_L(0); PG8_MMA(0, 1, At, B1); PG8_BAR;
            PG8_LDA(At, 1, 1); PG8_STAGE(PG8_SA(1, 0), a3, voffA);
            PG8_BAR; PG8_WAIT_L(0); PG8_MMA(1, 0, At, B0); PG8_BAR; PG8_SCHED;
            PG8_STAGE(PG8_SB(1, 1), b3 + hstep, voffB);
            PG8_WAIT_V(6); PG8_BAR; PG8_MMA(1, 1, At, B1); PG8_BAR;
            }
        }
        if constexpr (ALIGN_EPI) { if (wr == 0) PG8_BAR; }
        if constexpr (!Epi::AFTER_DRAIN) { E(acc, cur, wr, wc, fr, fq); S.done(cur); }
        if (!has_next) break;
#pragma unroll
        for (int a = 0; a < 2; ++a)
#pragma unroll
            for (int b = 0; b < 2; ++b)
#pragma unroll
                for (int m = 0; m < 4; ++m)
#pragma unroll
                    for (int n = 0; n < 2; ++n) acc[a][b][m][n] = (f32x4){0.f, 0.f, 0.f, 0.f};
        cur = nxt; cA = nA; cB = nB; ++ui;
        if constexpr (ALIGN_EPI) { if (wr == 1) PG8_BAR; }
    }
    PG8_WAIT_V(0);
    if constexpr (!ALIGN_EPI) { if (wr == 0) PG8_BAR; }
    PG8_BAR;
    if constexpr (Epi::AFTER_DRAIN) { E.fused(acc, cur, wr, wc, fr, fq, lds, wid, lane); S.done(cur); }
#undef PG8_SA
#undef PG8_SB
#undef PG8_STAGE
#undef PG8_LDA
#undef PG8_LDB
#undef PG8_MMA
#undef PG8_WAIT_V
#undef PG8_WAIT_L
#undef PG8_BAR
#undef PG8_SCHED
}
}

#define LAS __attribute__((address_space(3)))
typedef unsigned short bf16;
typedef unsigned v4u __attribute__((ext_vector_type(4)));
typedef unsigned v2u __attribute__((ext_vector_type(2)));
typedef float f32x4 __attribute__((ext_vector_type(4)));
typedef short bf16x8 __attribute__((ext_vector_type(8)));
typedef short s16x4 __attribute__((ext_vector_type(4)));
#define LDS_WAIT() asm volatile("s_waitcnt lgkmcnt(0)" ::: "memory")

constexpr int BATCH = 2, T = 8192, D = 1024, M = BATCH * T, FF = 2816, DIN = 1976, DINP = 2048, NMOD = 9 * D;
constexpr float ALPHA = 1.18920711500272f;
constexpr float LN_EPS = 1e-5f;
constexpr float QS_NSA = 0.125f * 1.4426950408889634f;
constexpr float QS_MLA = 0.10206207261596575f * 1.4426950408889634f;
constexpr int LDS_BYTES = 147456;
constexpr int NTHREADS = 512;

constexpr size_t MiB = 1u << 20;
constexpr size_t WS_CTL = 832 * 1024, CTL_BYTES = 16 * 1024;
constexpr size_t WS_MOD = 0, WS_POSB = 128 * 1024, WS_CS8 = 256 * 1024, WS_CS16 = 57 * MiB;
constexpr size_t WS_WGU1 = 1 * MiB, WS_WD1 = 12 * MiB, WS_WGU2 = 18 * MiB, WS_WD2 = 29 * MiB, WS_WIN = 35 * MiB, WS_WOUT = 39 * MiB, WS_WUQ = 41 * MiB, WS_WUKV = 42 * MiB,
                 WS_W1K = 43 * MiB, WS_W1V = 44 * MiB, WS_KCMP = 45 * MiB, WS_VCMP = 45 * MiB + 512 * 1024, WS_YK = 46 * MiB, WS_YV = 50 * MiB, WS_GATES = 54 * MiB, WS_KR = 56 * MiB,
                 WS_U = 58 * MiB, WS_BIG = 90 * MiB;
constexpr size_t WS_HFF = WS_BIG, WS_H = WS_BIG, WS_QMLA = WS_BIG, WS_KVMLA = WS_BIG + 24 * MiB, WS_QN = WS_BIG + 64 * MiB, WS_KV6 = WS_BIG + 80 * MiB, WS_CQN = WS_BIG + 104 * MiB, WS_CKVN = WS_BIG + 116 * MiB;
constexpr size_t KV6_SEG = (size_t)BATCH * 2 * T * 64;
constexpr size_t WS_END = WS_BIG + 124 * MiB;
static_assert(WS_END <= 256 * MiB, "ws map");

struct Args { const float* in[24]; float* out; unsigned char* ws; double inv8[8]; double inv16[16]; };

__device__ __forceinline__ float wave_sum(float v) {
#pragma unroll
    for (int o = 1; o < 64; o <<= 1) v += __shfl_xor(v, o);
    return v;
}
__device__ __forceinline__ unsigned f2bf(float f) { unsigned u = __builtin_bit_cast(unsigned, f); return (u + 0x7fffu + ((u >> 16) & 1u)) >> 16; }
__device__ __forceinline__ unsigned pk2(float lo, float hi) { return f2bf(lo) | (f2bf(hi) << 16); }
__device__ __forceinline__ float bf2f(unsigned short h) { return __builtin_bit_cast(float, (unsigned)h << 16); }
__device__ __forceinline__ void rope_cs(int pos, double invrev, float& c, float& s) {
    double a = (double)pos * invrev; a -= __builtin_floor(a); const float f = (float)a;
    s = __builtin_amdgcn_sinf(f); c = __builtin_amdgcn_cosf(f);
}

namespace pg8 {
struct EpiSwiglu {
    static constexpr bool PERM = true, AFTER_DRAIN = false;
    bf16_t* O; int ldc;
    __device__ __forceinline__ void operator()(const f32x4 (&acc)[2][2][4][2], const Unit& u, int wr, int wc, int fr, int fq) const {
        const int row0 = u.pm * BM + wr * 64 + fr, col0 = u.pn * 128 + wc * 32 + 8 * fq;
#pragma unroll
        for (int ai = 0; ai < 2; ++ai)
#pragma unroll
            for (int m = 0; m < 4; ++m) {
                bf16_t* rowp = O + (size_t)(row0 + ai * HALF + m * 16) * ldc + col0;
                float h[8];
#pragma unroll
                for (int n = 0; n < 2; ++n)
#pragma unroll
                    for (int e = 0; e < 4; ++e) { const float g = acc[ai][0][m][n][e], up = acc[ai][1][m][n][e]; h[4 * n + e] = g * __builtin_amdgcn_rcpf(1.f + __expf(-g)) * up; }
                u32x4 w; w.x = cvt_pk_bf16(h[0], h[1]); w.y = cvt_pk_bf16(h[2], h[3]); w.z = cvt_pk_bf16(h[4], h[5]); w.w = cvt_pk_bf16(h[6], h[7]);
                *(u32x4*)rowp = w;
            }
    }
};
struct EpiResid {
    static constexpr bool PERM = false, AFTER_DRAIN = false;
    const float* xin; float* out; const float* gate; float coef;
    __device__ __forceinline__ void operator()(const f32x4 (&acc)[2][2][4][2], const Unit& u, int wr, int wc, int fr, int fq) const {
        const int row0 = u.pm * BM + wr * 64 + fr, col0 = u.pn * BM + wc * 32 + 4 * fq;
#pragma unroll
        for (int ai = 0; ai < 2; ++ai)
#pragma unroll
            for (int m = 0; m < 4; ++m) {
                const int row = row0 + ai * HALF + m * 16; const int b = row >> 13;
#pragma unroll
                for (int bj = 0; bj < 2; ++bj)
#pragma unroll
                    for (int n = 0; n < 2; ++n) {
                        const int col = col0 + bj * HALF + n * 16;
                        const f32x4 gv = *(const f32x4*)(gate + (size_t)b * 9216 + col);
                        const f32x4 xv = *(const f32x4*)(xin + (size_t)row * 1024 + col);
                        const f32x4 o = xv * ALPHA + (gv + 1.0f) * coef * acc[ai][bj][m][n];
                        *(f32x4*)(out + (size_t)row * 1024 + col) = o;
                    }
            }
    }
};
struct EpiF32 {
    static constexpr bool PERM = false, AFTER_DRAIN = false;
    float* out; int ldc;
    __device__ __forceinline__ void operator()(const f32x4 (&acc)[2][2][4][2], const Unit& u, int wr, int wc, int fr, int fq) const {
        const int row0 = u.pm * BM + wr * 64 + fr, col0 = u.pn * BM + wc * 32 + 4 * fq;
#pragma unroll
        for (int ai = 0; ai < 2; ++ai)
#pragma unroll
            for (int m = 0; m < 4; ++m)
#pragma unroll
                for (int bj = 0; bj < 2; ++bj)
#pragma unroll
                    for (int n = 0; n < 2; ++n) *(f32x4*)(out + (size_t)(row0 + ai * HALF + m * 16) * ldc + col0 + bj * HALF + n * 16) = acc[ai][bj][m][n];
    }
};
struct EpiQmla {
    static constexpr bool PERM = false, AFTER_DRAIN = false;
    bf16_t* O; const float* cst;
    __device__ __forceinline__ void operator()(const f32x4 (&acc)[2][2][4][2], const Unit& u, int wr, int wc, int fr, int fq) const {
        const int row0 = u.pm * BM + wr * 64 + fr, col0 = u.pn * BM + wc * 32 + 4 * fq;
        if (u.pn < 2) {
#pragma unroll
            for (int ai = 0; ai < 2; ++ai)
#pragma unroll
                for (int m = 0; m < 4; ++m)
#pragma unroll
                    for (int bj = 0; bj < 2; ++bj)
#pragma unroll
                        for (int n = 0; n < 2; ++n) { const f32x4 v = acc[ai][bj][m][n] * QS_MLA; unsigned lo = cvt_pk_bf16(v[0], v[1]), hi = cvt_pk_bf16(v[2], v[3]);
                            unsigned long long w = (unsigned long long)lo | ((unsigned long long)hi << 32);
                            *(unsigned long long*)(O + (size_t)(row0 + ai * HALF + m * 16) * 768 + col0 + bj * HALF + n * 16) = w; }
        } else {
#pragma unroll
            for (int ai = 0; ai < 2; ++ai)
#pragma unroll
                for (int m = 0; m < 4; ++m) {
                    const int row = row0 + ai * HALF + m * 16; const int pos = row & 8191;
                    const f32x4 cs = *(const f32x4*)(cst + (size_t)pos * 32 + 4 * fq), sn = *(const f32x4*)(cst + (size_t)pos * 32 + 16 + 4 * fq);
#pragma unroll
                    for (int bj = 0; bj < 2; ++bj) {
                        const f32x4 x1 = acc[ai][bj][m][0], x2 = acc[ai][bj][m][1];
                        const f32x4 o1 = (x1 * cs - x2 * sn) * QS_MLA, o2 = (x2 * cs + x1 * sn) * QS_MLA;
                        bf16_t* p = O + (size_t)row * 768 + col0 + bj * HALF;
                        *(unsigned long long*)(p) = (unsigned long long)cvt_pk_bf16(o1[0], o1[1]) | ((unsigned long long)cvt_pk_bf16(o1[2], o1[3]) << 32);
                        *(unsigned long long*)(p + 16) = (unsigned long long)cvt_pk_bf16(o2[0], o2[1]) | ((unsigned long long)cvt_pk_bf16(o2[2], o2[3]) << 32);
                    }
                }
        }
    }
};
}

namespace att {
constexpr int OFF_K = 0, OFF_V = 13312, BUFSZ = 22528, OFF_SEL = 2 * BUFSZ, OFF_IMP = OFF_SEL + 1024, OFF_OC = OFF_IMP + 64 * 132 * 4, OFF_END = OFF_OC + 8 * 512 * 16;
static_assert(OFF_END <= 147456 - 64 && OFF_OC % 16 == 0, "attention LDS map");
constexpr int VSTR = 72, ISTR = 132;
enum { CAUSAL = 0, WINDOW = 1, CMP = 2, SEL = 3 };
constexpr float NEG = -1e30f;

template <int DQK> struct Stage { v4u k0, k1, v; };

template <int DQK> __device__ __forceinline__ void stage_load(Stage<DQK>& s, const bf16* K0, int p0, const bf16* K1, int p1, const bf16* V, int pv, int tile, bool withV, int tid) {
    { const int key = tid >> 3, c = tid & 7; s.k0 = *(const v4u*)(K0 + (size_t)(64 * tile + key) * p0 + 8 * c); }
    if (DQK == 96) { if (tid < 256) { const int key = tid >> 2, c = tid & 3; s.k1 = *(const v4u*)(K1 + (size_t)(64 * tile + key) * p1 + 8 * c); } }
    if (withV) { const int w = tid >> 6, ky = tid & 63; s.v = *(const v4u*)(V + (size_t)(64 * tile + ky) * pv + 8 * w); }
}
template <int DQK> __device__ __forceinline__ void stage_store(const Stage<DQK>& s, LAS unsigned char* lds, bool withV, int tid) {
    constexpr int KSTR = DQK + 8;
    { const int key = tid >> 3, c = tid & 7; *(LAS v4u*)(lds + OFF_K + (key * KSTR + 8 * c) * 2) = s.k0; }
    if (DQK == 96) { if (tid < 256) { const int key = tid >> 2, c = tid & 3; *(LAS v4u*)(lds + OFF_K + (key * KSTR + 64 + 8 * c) * 2) = s.k1; } }
    if (withV) { const int w = tid >> 6, ky = tid & 63; LAS unsigned short* vt = (LAS unsigned short*)(lds + OFF_V);
#pragma unroll
        for (int e = 0; e < 8; ++e) vt[(8 * w + e) * VSTR + ky] = (unsigned short)((s.v[e >> 1] >> (16 * (e & 1))) & 0xffffu); }
}

template <int DQK> __device__ __forceinline__ void qk_tile(LAS unsigned char* lds, const bf16x8 (&qf)[DQK / 32], f32x4 (&s)[4], int fr, int fq) {
    constexpr int KSTR = DQK + 8, NKS = DQK / 32;
#pragma unroll
    for (int ss = 0; ss < 4; ++ss) {
        s[ss] = (f32x4){0.f, 0.f, 0.f, 0.f};
#pragma unroll
        for (int ks = 0; ks < NKS; ++ks) {
            const bf16x8 kf = *(const LAS bf16x8*)(lds + OFF_K + ((16 * ss + fr) * KSTR + 32 * ks + 8 * fq) * 2);
            s[ss] = __builtin_amdgcn_mfma_f32_16x16x32_bf16(kf, qf[ks], s[ss], 0, 0, 0);
        }
    }
}
template <int MODE> __device__ __forceinline__ bool key_ok(int kpos, int tpos, bool rowsel) {
    if (MODE == CAUSAL) return kpos <= tpos;
    if (MODE == WINDOW) return kpos <= tpos && kpos + 512 > tpos;
    if (MODE == CMP) return 16 * kpos + 31 <= tpos;
    return rowsel && kpos <= tpos;
}
typedef float f32x2_t __attribute__((ext_vector_type(2))); typedef __bf16 bf16x2_t __attribute__((ext_vector_type(2)));
__device__ __forceinline__ unsigned cvtpk(float lo, float hi) { f32x2_t v = {lo, hi}; bf16x2_t b = __builtin_convertvector(v, bf16x2_t); return __builtin_bit_cast(unsigned, b); }
__device__ __forceinline__ float rows_max(float v) {
    auto a = __builtin_amdgcn_permlane16_swap(__float_as_uint(v), __float_as_uint(v), false, false); v = fmaxf(__uint_as_float(a[0]), __uint_as_float(a[1]));
    auto c = __builtin_amdgcn_permlane32_swap(__float_as_uint(v), __float_as_uint(v), false, false); return fmaxf(__uint_as_float(c[0]), __uint_as_float(c[1]));
}
__device__ __forceinline__ float rows_sum(float v) {
    auto a = __builtin_amdgcn_permlane16_swap(__float_as_uint(v), __float_as_uint(v), false, false); v = __uint_as_float(a[0]) + __uint_as_float(a[1]);
    auto c = __builtin_amdgcn_permlane32_swap(__float_as_uint(v), __float_as_uint(v), false, false); return __uint_as_float(c[0]) + __uint_as_float(c[1]);
}
template <int DQK, int MODE, bool FULL> __device__ __forceinline__ void qt_tile(LAS unsigned char* lds, const bf16x8 (&qf)[DQK / 32], int kbase, int tpos, bool rowsel, float& m, float& l, f32x4 (&o)[4], int fr, int fq) {
    f32x4 s[4];
    qk_tile<DQK>(lds, qf, s, fr, fq);
    float mx;
    if (FULL) {
        mx = fmaxf(fmaxf(s[0][0], s[0][1]), fmaxf(s[0][2], s[0][3]));
#pragma unroll
        for (int ss = 1; ss < 4; ++ss) mx = fmaxf(mx, fmaxf(fmaxf(s[ss][0], s[ss][1]), fmaxf(s[ss][2], s[ss][3])));
    } else {
        mx = NEG;
#pragma unroll
        for (int ss = 0; ss < 4; ++ss)
#pragma unroll
            for (int i = 0; i < 4; ++i) { const bool ok = key_ok<MODE>(kbase + 16 * ss + 4 * fq + i, tpos, rowsel); const float v = ok ? s[ss][i] : NEG; s[ss][i] = v; mx = fmaxf(mx, v); }
    }
    mx = rows_max(mx);
    if (__any(mx > m ? 1 : 0)) {
        const float mnew = fmaxf(m, mx); const float alpha = __builtin_amdgcn_exp2f(m - mnew);
        l *= alpha; m = mnew;
#pragma unroll
        for (int dt = 0; dt < 4; ++dt) o[dt] = o[dt] * alpha;
    }
    float rs = 0.f;
#pragma unroll
    for (int ss = 0; ss < 4; ++ss)
#pragma unroll
        for (int i = 0; i < 4; ++i) { const float v = s[ss][i]; float p = __builtin_amdgcn_exp2f(v - m); if (!FULL && MODE != CAUSAL) p = (v > -1e29f) ? p : 0.f; s[ss][i] = p; rs += p; }
    l += rs;
    bf16x8 pb[2];
#pragma unroll
    for (int j = 0; j < 2; ++j) {
        const v4u w = (v4u){cvtpk(s[2 * j][0], s[2 * j][1]), cvtpk(s[2 * j][2], s[2 * j][3]), cvtpk(s[2 * j + 1][0], s[2 * j + 1][1]), cvtpk(s[2 * j + 1][2], s[2 * j + 1][3])};
        pb[j] = __builtin_bit_cast(bf16x8, w);
    }
#pragma unroll
    for (int dt = 0; dt < 4; ++dt)
#pragma unroll
        for (int j = 0; j < 2; ++j) {
            const LAS unsigned char* vp = lds + OFF_V + ((16 * dt + fr) * VSTR + 32 * j + 4 * fq) * 2;
            const v2u lo = *(const LAS v2u*)vp, hi = *(const LAS v2u*)(vp + 32);
            const v4u w = (v4u){lo.x, lo.y, hi.x, hi.y};
            o[dt] = __builtin_amdgcn_mfma_f32_16x16x32_bf16(__builtin_bit_cast(bf16x8, w), pb[j], o[dt], 0, 0, 0);
        }
}

template <int DQK, int MODE> __device__ __forceinline__ void attn_pass(LAS unsigned char* lds, const bf16* K0, int p0, const bf16* K1, int p1, const bf16* V, int pv, int tlo, int thi,
        const bf16x8 (&qf)[2][DQK / 32], const int (&tpos)[2], const int (&tok)[2], int wave_tmin, int wave_tmax, f32x4 (&o)[2][4], float (&mfin)[2], float (&linv)[2], int tid, int fr, int fq) {
    asm volatile("" : "+v"(tid)); asm volatile("" : "+s"(K0), "+s"(V)); if (DQK == 96) asm volatile("" : "+s"(K1));
    fr = tid & 15; fq = (tid & 63) >> 4;
    float m[2] = {NEG, NEG}, l[2] = {0.f, 0.f};
#pragma unroll
    for (int i = 0; i < 2; ++i)
#pragma unroll
        for (int dt = 0; dt < 4; ++dt) o[i][dt] = (f32x4){0.f, 0.f, 0.f, 0.f};
    Stage<DQK> st;
    stage_load<DQK>(st, K0, p0, K1, p1, V, pv, tlo, true, tid);
    stage_store<DQK>(st, lds, true, tid);
    __syncthreads();
    for (int t = tlo; t <= thi; ++t) {
        LAS unsigned char* buf = lds + ((t - tlo) & 1) * BUFSZ;
        if (t < thi) stage_load<DQK>(st, K0, p0, K1, p1, V, pv, t + 1, true, tid);
        const int kbase = 64 * t;
        const bool skip = (MODE == CMP) ? (16 * kbase + 31 > wave_tmax) : (kbase > wave_tmax);
        if (!skip) {
            bool full = (MODE == CMP) ? (16 * (kbase + 63) + 31 <= wave_tmin) : (kbase + 63 <= wave_tmin);
            if (MODE == WINDOW) full = full && (kbase + 512 > wave_tmax);
#pragma unroll
            for (int i = 0; i < 2; ++i) {
                bool rowsel = true; bool fl = full;
                if (MODE == SEL) { const unsigned w = ((const LAS unsigned*)(lds + OFF_SEL))[tok[i] * 4 + (t >> 5)]; rowsel = ((w >> (t & 31)) & 1u) != 0u; if (!__any(rowsel ? 1 : 0)) continue; fl = full && __all(rowsel ? 1 : 0); }
                if (fl) qt_tile<DQK, MODE, true>(buf, qf[i], kbase, tpos[i], rowsel, m[i], l[i], o[i], fr, fq);
                else qt_tile<DQK, MODE, false>(buf, qf[i], kbase, tpos[i], rowsel, m[i], l[i], o[i], fr, fq);
            }
        }
        if (t < thi) stage_store<DQK>(st, lds + (((t - tlo) & 1) ^ 1) * BUFSZ, true, tid);
        __syncthreads();
    }
#pragma unroll
    for (int i = 0; i < 2; ++i) {
        const float lt = rows_sum(l[i]);
        const float iv = lt > 0.f ? 1.0f / lt : 0.f;
        mfin[i] = m[i]; linv[i] = iv;
#pragma unroll
        for (int dt = 0; dt < 4; ++dt) o[i][dt] = o[i][dt] * iv;
    }
}

struct NsaPtrs { const bf16 *QN, *KV6, *KCMP, *VCMP; const float* GATES; bf16* OCAT; };

__device__ __forceinline__ void nsa_load_q(const bf16* QN, int b, int g, int tid, int t0, bf16x8 (&qf)[2][2]) {
    asm volatile("" : "+v"(tid)); asm volatile("" : "+s"(QN));
    const int wave = tid >> 6, fr = tid & 15, fq = (tid & 63) >> 4, hh = fr >> 2;
#pragma unroll
    for (int i = 0; i < 2; ++i) {
        const size_t mrow = (size_t)b * T + t0 + 8 * wave + 4 * i + (fr & 3);
        const bf16* qrow = QN + mrow * 512 + (g * 4 + hh) * 64;
#pragma unroll
        for (int ks = 0; ks < 2; ++ks) qf[i][ks] = *(const bf16x8*)(qrow + 32 * ks + 8 * fq);
    }
}
__device__ __forceinline__ void nsa_item(LAS unsigned char* lds, const NsaPtrs& P, int b, int g, int qb, int tid) {
    const int wave = tid >> 6, lane = tid & 63, fr = lane & 15, fq = lane >> 4, hh = fr >> 2;
    const int t0 = 64 * qb; const size_t bg = (size_t)(b * 2 + g);
    int tpos[2], tok[2];
#pragma unroll
    for (int i = 0; i < 2; ++i) { tok[i] = 8 * wave + 4 * i + (fr & 3); tpos[i] = t0 + tok[i]; }
    const int wave_tmin = t0 + 8 * wave, wave_tmax = t0 + 8 * wave + 7;
    LAS float* imp = (LAS float*)(lds + OFF_IMP);
    LAS f32x4* ocl = (LAS f32x4*)(lds + OFF_OC);
    for (int idx = tid; idx < 64 * ISTR; idx += NTHREADS) imp[idx] = 0.f;
    bf16x8 qf[2][2]; f32x4 o[2][4]; float mf[2], li[2];
    const bf16* Kc = P.KCMP + bg * 512 * 64; const bf16* Vc = P.VCMP + bg * 512 * 64;
    const int thi_c = ((t0 + 63 - 31) >> 4) >> 6;
    nsa_load_q(P.QN, b, g, tid, t0, qf);
    attn_pass<64, CMP>(lds, Kc, 64, nullptr, 0, Vc, 64, 0, thi_c, qf, tpos, tok, wave_tmin, wave_tmax, o, mf, li, tid, fr, fq);
#pragma unroll
    for (int i = 0; i < 2; ++i) { const float gc = P.GATES[((size_t)b * T + tpos[i]) * 24 + g * 12 + hh * 3 + 0];
#pragma unroll
        for (int dt = 0; dt < 4; ++dt) ocl[(i * 4 + dt) * NTHREADS + tid] = o[i][dt] * gc; }
#ifndef NSA_NO_IMP
    int tid_i = tid; asm volatile("" : "+v"(tid_i)); const int fr_i = tid_i & 15, fq_i = (tid_i & 63) >> 4; asm volatile("" : "+s"(Kc));
    for (int t = 0; t <= thi_c; ++t) {
        __syncthreads();
        { const int key = tid_i >> 3, c = tid_i & 7; *(LAS v4u*)(lds + OFF_K + (key * 72 + 8 * c) * 2) = *(const v4u*)(Kc + (size_t)(64 * t + key) * 64 + 8 * c); }
        __syncthreads();
        if (16 * (64 * t) + 31 > wave_tmax) continue;
#pragma unroll
        for (int i = 0; i < 2; ++i) {
            f32x4 s[4];
            qk_tile<64>(lds, qf[i], s, fr_i, fq_i);
#pragma unroll
            for (int ss = 0; ss < 4; ++ss) {
                float a = 0.f, b3 = 0.f;
#pragma unroll
                for (int e = 0; e < 4; ++e) { const int n = 64 * t + 16 * ss + 4 * fq_i + e; const float p = (16 * n + 31 <= tpos[i]) ? __builtin_amdgcn_exp2f(s[ss][e] - mf[i]) * li[i] : 0.f; a += p; if (e == 3) b3 = p; }
                a += __shfl_xor(a, 4); a += __shfl_xor(a, 8); b3 += __shfl_xor(b3, 4); b3 += __shfl_xor(b3, 8);
                if (fr_i < 4) { const int jp = 16 * t + 4 * ss + fq_i;
                    __hip_atomic_fetch_add(imp + tok[i] * ISTR + jp, a, __ATOMIC_RELAXED, __HIP_MEMORY_SCOPE_WORKGROUP);
                    __hip_atomic_fetch_add(imp + tok[i] * ISTR + jp + 1, b3, __ATOMIC_RELAXED, __HIP_MEMORY_SCOPE_WORKGROUP); }
            }
        }
    }
#endif
    __syncthreads();
#ifndef NSA_NO_TOPK
    {
        int tid_k = tid; asm volatile("" : "+v"(tid_k)); const int tk = tid_k >> 3, part = tid_k & 7;
        float v[16]; int cnt[16];
#pragma unroll
        for (int jj = 0; jj < 16; ++jj) { const int j = part * 16 + jj; const bool causal = j <= qb, forced = (j == 0) || (j == qb) || (j == qb - 1);
            const float val = !causal ? -1.0f : (forced ? 1e9f : imp[tk * ISTR + j]); v[jj] = val; cnt[jj] = 0; }
        __syncthreads();
#pragma unroll
        for (int jj = 0; jj < 16; ++jj) imp[tk * ISTR + part * 16 + jj] = v[jj];
        __syncthreads();
        for (int k = 0; k <= qb; ++k) { const float vk = imp[tk * ISTR + k];
#pragma unroll
            for (int jj = 0; jj < 16; ++jj) { const int j = part * 16 + jj; cnt[jj] += ((vk > v[jj]) || (vk == v[jj] && k < j)) ? 1 : 0; } }
        unsigned bits = 0u;
#pragma unroll
        for (int jj = 0; jj < 16; ++jj) { const int j = part * 16 + jj; if (j <= qb && cnt[jj] < 16) bits |= (1u << jj); }
        ((LAS unsigned short*)(lds + OFF_SEL))[tk * 8 + part] = (unsigned short)bits;
    }
#endif
    __syncthreads();
#ifndef NSA_NO_SEL
    nsa_load_q(P.QN, b, g, tid, t0, qf);
    attn_pass<64, SEL>(lds, P.KV6 + 2 * KV6_SEG + bg * T * 64, 64, nullptr, 0, P.KV6 + 3 * KV6_SEG + bg * T * 64, 64, 0, qb, qf, tpos, tok, wave_tmin, wave_tmax, o, mf, li, tid, fr, fq);
#pragma unroll
    for (int i = 0; i < 2; ++i) { const float gs = P.GATES[((size_t)b * T + tpos[i]) * 24 + g * 12 + hh * 3 + 1];
#pragma unroll
        for (int dt = 0; dt < 4; ++dt) ocl[(i * 4 + dt) * NTHREADS + tid] += o[i][dt] * gs; }
#endif
    nsa_load_q(P.QN, b, g, tid, t0, qf);
    attn_pass<64, WINDOW>(lds, P.KV6 + 4 * KV6_SEG + bg * T * 64, 64, nullptr, 0, P.KV6 + 5 * KV6_SEG + bg * T * 64, 64, (qb >= 8 ? qb - 8 : 0), qb, qf, tpos, tok, wave_tmin, wave_tmax, o, mf, li, tid, fr, fq);
#pragma unroll
    for (int i = 0; i < 2; ++i) {
        const float gw = P.GATES[((size_t)b * T + tpos[i]) * 24 + g * 12 + hh * 3 + 2];
        bf16* orow = P.OCAT + ((size_t)b * T + tpos[i]) * 1024 + (g * 4 + hh) * 64 + 4 * fq;
#pragma unroll
        for (int dt = 0; dt < 4; ++dt) { const f32x4 r = ocl[(i * 4 + dt) * NTHREADS + tid] + o[i][dt] * gw;
            *(unsigned long long*)(orow + 16 * dt) = (unsigned long long)pk2(r[0], r[1]) | ((unsigned long long)pk2(r[2], r[3]) << 32); }
    }
}

struct MlaPtrs { const bf16 *QMLA, *KVMLA, *KR; bf16* OCAT; };
__device__ __forceinline__ void mla_item(LAS unsigned char* lds, const MlaPtrs& P, int b, int h, int qb, int tid) {
    const int wave = tid >> 6, lane = tid & 63, fr = lane & 15, fq = lane >> 4;
    const int t0 = 256 * qb;
    int tpos[2], tok[2]; bf16x8 qf[2][3];
#pragma unroll
    for (int i = 0; i < 2; ++i) {
        tok[i] = 0; tpos[i] = t0 + 32 * wave + 16 * i + fr;
        const bf16* qrow = P.QMLA + ((size_t)b * T + tpos[i]) * 768;
        qf[i][0] = *(const bf16x8*)(qrow + h * 64 + 8 * fq); qf[i][1] = *(const bf16x8*)(qrow + h * 64 + 32 + 8 * fq); qf[i][2] = *(const bf16x8*)(qrow + 512 + h * 32 + 8 * fq);
    }
    const int wave_tmin = t0 + 32 * wave, wave_tmax = t0 + 32 * wave + 31;
    f32x4 o[2][4]; float mf[2], li[2];
    const bf16* kv = P.KVMLA + (size_t)b * T * 1024;
    attn_pass<96, CAUSAL>(lds, kv + h * 64, 1024, P.KR + (size_t)b * T * 32, 32, kv + 512 + h * 64, 1024, 0, 4 * qb + 3, qf, tpos, tok, wave_tmin, wave_tmax, o, mf, li, tid, fr, fq);
#pragma unroll
    for (int i = 0; i < 2; ++i) {
        bf16* orow = P.OCAT + ((size_t)b * T + tpos[i]) * 1024 + 512 + h * 64 + 4 * fq;
#pragma unroll
        for (int dt = 0; dt < 4; ++dt) { const f32x4 r = o[i][dt];
            *(unsigned long long*)(orow + 16 * dt) = (unsigned long long)pk2(r[0], r[1]) | ((unsigned long long)pk2(r[2], r[3]) << 32); }
    }
}
}

__device__ __forceinline__ void tr_item(const float* W, int N, int k0, int n0, bf16* WT, int Kd, int drow0, int dk0, LAS float* scr, int lane) {
#pragma unroll 8
    for (int i = 0; i < 32; ++i) { const int kk = 2 * i + (lane >> 5); const int n = n0 + (lane & 31); scr[kk * 33 + (lane & 31)] = (n < N) ? W[(size_t)(k0 + kk) * N + n] : 0.f; }
    LDS_WAIT();
    const int c = lane & 7;
#pragma unroll
    for (int j = 0; j < 4; ++j) { const int n = (lane >> 3) + 8 * j; const LAS float* s = scr + (8 * c) * 33 + n;
        v4u o; o.x = pk2(s[0 * 33], s[1 * 33]); o.y = pk2(s[2 * 33], s[3 * 33]); o.z = pk2(s[4 * 33], s[5 * 33]); o.w = pk2(s[6 * 33], s[7 * 33]);
        *(v4u*)(WT + (size_t)(drow0 + n) * Kd + dk0 + 8 * c) = o; }
    LDS_WAIT();
}

template <bool DO_LN, bool DO_U> __device__ __forceinline__ void row_pass(const float* xin, float* xout, const float* lng, const float* lnb, const float* mod, int sh_off, int sc_off, bf16* U, int gw, int NGW, int lane) {
    for (int m = gw; m < M; m += NGW) {
        const int b = m >> 13;
        const f32x4* xr = (const f32x4*)(xin + (size_t)m * D) + lane;
        f32x4 v[4];
#pragma unroll
        for (int j = 0; j < 4; ++j) v[j] = xr[64 * j];
        if (DO_LN) {
            float s = 0.f;
#pragma unroll
            for (int j = 0; j < 4; ++j) s += (v[j].x + v[j].y) + (v[j].z + v[j].w);
            const float mean = wave_sum(s) * (1.f / D); float s2 = 0.f;
#pragma unroll
            for (int j = 0; j < 4; ++j) { v[j] = v[j] - mean; s2 += (v[j].x * v[j].x + v[j].y * v[j].y) + (v[j].z * v[j].z + v[j].w * v[j].w); }
            const float rstd = 1.f / sqrtf(wave_sum(s2) * (1.f / D) + LN_EPS);
            f32x4* xo = (f32x4*)(xout + (size_t)m * D) + lane;
#pragma unroll
            for (int j = 0; j < 4; ++j) { const f32x4 gg = *((const f32x4*)lng + lane + 64 * j), bb = *((const f32x4*)lnb + lane + 64 * j); v[j] = v[j] * rstd * gg + bb; xo[64 * j] = v[j]; }
        }
        if (DO_U) {
            const f32x4* shp = (const f32x4*)(mod + (size_t)b * NMOD + sh_off) + lane; const f32x4* scp = (const f32x4*)(mod + (size_t)b * NMOD + sc_off) + lane;
            unsigned long long* o8 = (unsigned long long*)(U + (size_t)m * D) + lane;
#pragma unroll
            for (int j = 0; j < 4; ++j) { const f32x4 u = v[j] * (scp[64 * j] + 1.0f) + shp[64 * j];
                o8[64 * j] = (unsigned long long)pk2(u.x, u.y) | ((unsigned long long)pk2(u.z, u.w) << 32); }
        }
    }
}

#define GAS __attribute__((address_space(1)))
#define XB_TMO      128
#define XB_XCNT(j)  (256  + 64 * (j))
#define XB_XSUB(j)  (1280 + 64 * (j))
#define XB_XGEN(j)  (2304 + 64 * (j))
#define XB_TOP      3328
#define XB_TOPGEN   3392
#define XCD_BAR_WORDS 3456
#define XB_SPIN_CAP (1u << 18)

__device__ __forceinline__ unsigned xb_ld(unsigned* p)              { return __hip_atomic_load(p, __ATOMIC_RELAXED, __HIP_MEMORY_SCOPE_AGENT); }
__device__ __forceinline__ unsigned xb_add(unsigned* p, unsigned v) { return __hip_atomic_fetch_add(p, v, __ATOMIC_RELAXED, __HIP_MEMORY_SCOPE_AGENT); }
__device__ __forceinline__ unsigned xb_xcc_id() { return (unsigned)__builtin_amdgcn_s_getreg((3 << 11) | 20) & 0xFu; }
#define XB_SPIN(cond, bar) do { unsigned _sp = 0; while (cond) { __builtin_amdgcn_s_sleep(1); \
    if ((++_sp & 255u) == 0u) { if (xb_ld(&(bar)[XB_TMO])) break; if (_sp > XB_SPIN_CAP) { atomicAdd(&(bar)[XB_TMO], 1u); break; } } } } while (0)

struct XcdBarrier {
    unsigned* bar; unsigned x;
    volatile LAS unsigned* st;
};

__device__ __forceinline__ XcdBarrier xcd_barrier_post(unsigned* bar, volatile LAS unsigned* st) {
    XcdBarrier b; b.bar = bar; b.x = xb_xcc_id(); b.st = st;
    if (threadIdx.x == 0) (void)xb_add(&bar[XB_XCNT(b.x)], 1u);
    return b;
}
__device__ __forceinline__ void xcd_barrier_complete(unsigned* bar, unsigned x, unsigned& nloc, unsigned& nx) {
    const unsigned G = gridDim.x * gridDim.y * gridDim.z;
    unsigned sum, cnt, mine, sp = 0u;
    for (;;) {
        sum = 0u; cnt = 0u; mine = 0u;
#pragma unroll
        for (unsigned j = 0; j < 16; ++j) { const unsigned c = xb_ld(&bar[XB_XCNT(j)]); sum += c; cnt += (c > 0u) ? 1u : 0u; mine = (j == x) ? c : mine; }
        if (sum == G) break;
        __builtin_amdgcn_s_sleep(1);
        if ((++sp & 255u) == 0u) { if (xb_ld(&bar[XB_TMO])) break; if (sp > XB_SPIN_CAP) { atomicAdd(&bar[XB_TMO], 1u); break; } }
    }
    nloc = mine > 0u ? mine : 1u; nx = cnt > 0u ? cnt : 1u;
}

__device__ __forceinline__ void xcd_barrier(const XcdBarrier& b) {
    asm volatile("s_waitcnt vmcnt(0)" ::: "memory");
    __syncthreads();
    if (threadIdx.x == 0) {
        unsigned* bar = b.bar;
        __builtin_amdgcn_s_waitcnt(0);
        unsigned nloc = b.st[0], nx = b.st[1];
        if (nloc == 0u) { xcd_barrier_complete(bar, b.x, nloc, nx); b.st[0] = nloc; b.st[1] = nx; }
        const unsigned old = xb_add(&bar[XB_XSUB(b.x)], 1u);
        const unsigned gen = old / nloc;
        if (old + 1u == (gen + 1u) * nloc) {
            __builtin_amdgcn_fence(__ATOMIC_RELEASE, "agent");
            asm volatile("s_waitcnt vmcnt(0)" ::: "memory");
            const unsigned og = xb_add(&bar[XB_TOP], 1u);
            const unsigned tg = og / nx;
            if (og + 1u == (tg + 1u) * nx) xb_add(&bar[XB_TOPGEN], 1u);
            else XB_SPIN(xb_ld(&bar[XB_TOPGEN]) == tg, bar);
            __builtin_amdgcn_fence(__ATOMIC_ACQUIRE, "agent");
            xb_add(&bar[XB_XGEN(b.x)], 1u);
            asm volatile("s_waitcnt vmcnt(0)" ::: "memory");
        } else {
            XB_SPIN(xb_ld(&bar[XB_XGEN(b.x)]) == gen, bar);
            __builtin_amdgcn_fence(__ATOMIC_ACQUIRE, "agent");
            asm volatile("s_waitcnt vmcnt(0)" ::: "memory");
        }
    }
    __syncthreads();
}

__global__ void __launch_bounds__(NTHREADS, 2) mega_fwd(Args a_unused) {
    extern __shared__ __attribute__((aligned(16))) unsigned char lds_raw[];
    cg::grid_group grid = cg::this_grid();
    (void)a_unused;
    { volatile LAS unsigned* misc = (volatile LAS unsigned*)((LAS unsigned char*)lds_raw + LDS_BYTES - 64);
      if (threadIdx.x < 16) misc[threadIdx.x] = 0u;
      __syncthreads();
      (void)xcd_barrier_post((unsigned*)((const Args*)__builtin_amdgcn_kernarg_segment_ptr())->ws + WS_CTL / 4, misc + 8); }
#define PH_BEGIN { const Args* ap = (const Args*)__builtin_amdgcn_kernarg_segment_ptr(); asm volatile("" : "+s"(ap)); unsigned char* ws; { const unsigned long long w_ = (unsigned long long)ap->ws; const unsigned lo_ = __builtin_amdgcn_readfirstlane((unsigned)w_), hi_ = __builtin_amdgcn_readfirstlane((unsigned)(w_ >> 32)); ws = (unsigned char*)(((unsigned long long)hi_ << 32) | lo_); } asm volatile("" : "+s"(ws)); \
    LAS unsigned char* lds = (LAS unsigned char*)lds_raw; const int tid = threadIdx.x, lane = tid & 63, wave = __builtin_amdgcn_readfirstlane(tid >> 6); \
    const int G = gridDim.x, bx = blockIdx.x, gw = bx * 8 + wave, NGW = G * 8; (void)lane; (void)gw; (void)NGW; (void)lds;
#define PH_END } { XcdBarrier b_; b_.bar = (unsigned*)((const Args*)__builtin_amdgcn_kernarg_segment_ptr())->ws + WS_CTL / 4; b_.x = xb_xcc_id(); b_.st = (volatile LAS unsigned*)((LAS unsigned char*)lds_raw + LDS_BYTES - 64) + 8; xcd_barrier(b_); }
#define mod ((float*)(ws + WS_MOD))
#define posb ((float*)(ws + WS_POSB))
#define CS8 ((float*)(ws + WS_CS8))
#define CS16 ((float*)(ws + WS_CS16))
#define Wgu1 ((bf16*)(ws + WS_WGU1))
#define Wd1 ((bf16*)(ws + WS_WD1))
#define Wgu2 ((bf16*)(ws + WS_WGU2))
#define Wd2 ((bf16*)(ws + WS_WD2))
#define Win ((bf16*)(ws + WS_WIN))
#define Wout ((bf16*)(ws + WS_WOUT))
#define Wuq ((bf16*)(ws + WS_WUQ))
#define Wukv ((bf16*)(ws + WS_WUKV))
#define W1k ((bf16*)(ws + WS_W1K))
#define W1v ((bf16*)(ws + WS_W1V))
#define KCMP ((bf16*)(ws + WS_KCMP))
#define VCMP ((bf16*)(ws + WS_VCMP))
#define YK ((float*)(ws + WS_YK))
#define YV ((float*)(ws + WS_YV))
#define GATES ((float*)(ws + WS_GATES))
#define KR ((bf16*)(ws + WS_KR))
#define U ((bf16*)(ws + WS_U))
#define HFF ((bf16*)(ws + WS_HFF))
#define H ((bf16*)(ws + WS_H))
#define QMLA ((bf16*)(ws + WS_QMLA))
#define KVMLA ((bf16*)(ws + WS_KVMLA))
#define QN ((bf16*)(ws + WS_QN))
#define KV6 ((bf16*)(ws + WS_KV6))
#define CQN ((bf16*)(ws + WS_CQN))
#define CKVN ((bf16*)(ws + WS_CKVN))
#define XIN (ap->in[0])
#define XOUT (ap->out)

    PH_BEGIN
    {
        LAS float* sc = (LAS float*)(lds + 131072);
        for (int i = tid; i < 2 * D; i += NTHREADS) { const float cv = ap->in[1][i]; sc[i] = cv / (1.f + expf(-cv)); }
        __syncthreads();
        LAS float* red = (LAS float*)lds;
        for (int cb = bx; cb < 256; cb += G) {
            const int col = tid % 36, kc = tid / 36, j = 36 * cb + col;
            if (kc < 14) {
                float a0 = 0.f, a1 = 0.f; const int k1 = (kc * 74 + 74 < D) ? kc * 74 + 74 : D;
                for (int k = kc * 74; k < k1; ++k) { const float w = ap->in[2][(size_t)k * NMOD + j]; a0 += sc[k] * w; a1 += sc[D + k] * w; }
                red[(kc * 36 + col) * 2] = a0; red[(kc * 36 + col) * 2 + 1] = a1;
            }
            __syncthreads();
            if (tid < 72) { const int c2 = tid >> 1, bb = tid & 1; float s = ap->in[3][36 * cb + c2];
                for (int q = 0; q < 14; ++q) s += red[(q * 36 + c2) * 2 + bb];
                mod[(size_t)bb * NMOD + 36 * cb + c2] = s; }
            __syncthreads();
        }
        for (int o = gw; o < 512; o += NGW) {
            const int which = o >> 8, j = o & 255; const float* pe = ap->in[which ? 13 : 10]; const float* w1 = ap->in[which ? 14 : 11];
            float s = 0.f;
            for (int k = lane; k < 2048; k += 64) s += pe[k] * w1[(size_t)k * 256 + j];
            s = wave_sum(s);
            if (lane == 0) posb[which * 256 + j] = s;
        }
        for (int e = bx * NTHREADS + tid; e < 8192 * 24; e += G * NTHREADS) {
            const int pos = e / 24, i = e % 24; double iv = 0.0;
#pragma unroll
            for (int q = 0; q < 8; ++q) if (i == q) iv = ap->inv8[q];
#pragma unroll
            for (int q = 0; q < 16; ++q) if (i == 8 + q) iv = ap->inv16[q];
            float c_, s_; rope_cs(pos, iv, c_, s_);
            if (i < 8) { CS8[pos * 16 + i] = c_; CS8[pos * 16 + 8 + i] = s_; } else { CS16[pos * 32 + (i - 8)] = c_; CS16[pos * 32 + 16 + (i - 8)] = s_; }
        }
        __syncthreads();
        LAS float* scr = (LAS float*)(lds + wave * 16384);
        constexpr int I_GU = (D / 64) * (FF / 32), I_WD = (FF / 64) * (D / 32), I_IN = (D / 64) * (DINP / 32), I_W1 = (2048 / 64) * (256 / 32), I_UQ = (384 / 64) * (768 / 32),
                      I_UKV = (256 / 64) * (1024 / 32), I_OUT = (D / 64) * (D / 32);
        constexpr int NITEMS = 4 * I_GU + 2 * I_WD + I_IN + 2 * I_W1 + I_UQ + I_UKV + I_OUT;
        for (int it = gw; it < NITEMS; it += NGW) {
            int r = it;
#define TR_TRY(CNT, NBLK, ...) if (r < (CNT)) { const int k0 = 64 * (r / (NBLK)), n0 = 32 * (r % (NBLK)); (void)k0; (void)n0; __VA_ARGS__; continue; } r -= (CNT);
            TR_TRY(I_GU, FF / 32, tr_item(ap->in[6], FF, k0, n0, Wgu1, D, (n0 / 128) * 256 + (n0 % 128), k0, scr, lane))
            TR_TRY(I_GU, FF / 32, tr_item(ap->in[7], FF, k0, n0, Wgu1, D, (n0 / 128) * 256 + 128 + (n0 % 128), k0, scr, lane))
            TR_TRY(I_WD, D / 32, tr_item(ap->in[8], D, k0, n0, Wd1, FF, n0, k0, scr, lane))
            TR_TRY(I_GU, FF / 32, tr_item(ap->in[21], FF, k0, n0, Wgu2, D, (n0 / 128) * 256 + (n0 % 128), k0, scr, lane))
            TR_TRY(I_GU, FF / 32, tr_item(ap->in[22], FF, k0, n0, Wgu2, D, (n0 / 128) * 256 + 128 + (n0 % 128), k0, scr, lane))
            TR_TRY(I_WD, D / 32, tr_item(ap->in[23], D, k0, n0, Wd2, FF, n0, k0, scr, lane))
            TR_TRY(I_IN, DINP / 32, tr_item(ap->in[9], DIN, k0, n0, Win, D, n0, k0, scr, lane))
            TR_TRY(I_W1, 256 / 32, tr_item(ap->in[11], 256, k0, n0, W1k, 1024, (k0 >= 1024 ? 256 : 0) + n0, k0 & 1023, scr, lane))
            TR_TRY(I_W1, 256 / 32, tr_item(ap->in[14], 256, k0, n0, W1v, 1024, (k0 >= 1024 ? 256 : 0) + n0, k0 & 1023, scr, lane))
            TR_TRY(I_UQ, 768 / 32, { const int hq = n0 / 96, jq = (n0 % 96) / 32; tr_item(ap->in[18], 768, k0, n0, Wuq, 384, jq < 2 ? hq * 64 + 32 * jq : 512 + hq * 32, k0, scr, lane); })
            TR_TRY(I_UKV, 1024 / 32, { const int hk = n0 / 128, ek = n0 % 128; tr_item(ap->in[19], 1024, k0, n0, Wukv, 256, ek < 64 ? hk * 64 + ek : 512 + hk * 64 + (ek - 64), k0, scr, lane); })
            TR_TRY(I_OUT, D / 32, tr_item(ap->in[20], D, k0, n0, Wout, D, n0, k0, scr, lane))
#undef TR_TRY
        }
    }
    } grid.sync();

    PH_BEGIN
    row_pass<false, true>(XIN, nullptr, nullptr, nullptr, mod, 0 * D, 1 * D, U, gw, NGW, lane);
    PH_END

    PH_BEGIN
#if !defined(ONLY_G) || ONLY_G == 1
    { int Kq = D; asm volatile("" : "+s"(Kq)); pg8::Gemm g{U, Wgu1, M, 2 * FF, Kq}; pg8::StaticOrder S; S.init(M, 2 * FF, G, bx); pg8::EpiSwiglu E{HFF, FF};
      pg8::gemm_phase<pg8::EpiSwiglu, pg8::StaticOrder, true, true>(lds, g, S, E); }
#endif
    PH_END
    PH_BEGIN
#if !defined(ONLY_G) || ONLY_G == 2
    { int Kq = FF; asm volatile("" : "+s"(Kq)); pg8::Gemm g{HFF, Wd1, M, D, Kq}; pg8::StaticOrder S; S.init(M, D, G, bx); pg8::EpiResid E{XIN, XOUT, mod + 2 * D, 0.5f};
      pg8::gemm_phase<pg8::EpiResid, pg8::StaticOrder, true, true>(lds, g, S, E); }
#endif
    PH_END
    PH_BEGIN
    row_pass<true, true>(XOUT, XOUT, ap->in[4] + 0 * D, ap->in[5] + 0 * D, mod, 3 * D, 4 * D, U, gw, NGW, lane);
    PH_END
    PH_BEGIN
#if !defined(ONLY_G) || ONLY_G == 3
    { int Kq = D; asm volatile("" : "+s"(Kq)); pg8::Gemm g{U, Win, M, DINP, Kq}; pg8::StaticOrder S; S.init(M, DINP, G, bx); pg8::EpiBf16<0> E{H, DINP, nullptr, 0, 0, 1.f};
      pg8::gemm_phase<pg8::EpiBf16<0>, pg8::StaticOrder, true, true>(lds, g, S, E); }
#endif
    PH_END
    PH_BEGIN
    {
        LAS v4u* rb = (LAS v4u*)(lds + wave * 4096); LAS unsigned short* hb = (LAS unsigned short*)rb;
        for (int m = gw; m < M; m += NGW) {
            const int b = m >> 13, t = m & 8191;
            const v4u* hr = (const v4u*)(H + (size_t)m * DINP);
#pragma unroll
            for (int j = 0; j < 4; ++j) rb[lane + 64 * j] = hr[lane + 64 * j];
            LDS_WAIT();
            {
                const int base = 8 * lane, d0 = 8 * (lane & 7); float v[8];
#pragma unroll
                for (int e = 0; e < 8; ++e) v[e] = bf2f(hb[base + e]);
                if (d0 < 16) {
#pragma unroll
                    for (int e = 0; e < 8; ++e) { const float c_ = CS8[t * 16 + e], s_ = CS8[t * 16 + 8 + e]; const float pr = bf2f(hb[base + e + (d0 == 0 ? 8 : -8)]); v[e] = (d0 == 0) ? v[e] * c_ - pr * s_ : v[e] * c_ + pr * s_; }
                }
                v4u o; o.x = pk2(v[0] * QS_NSA, v[1] * QS_NSA); o.y = pk2(v[2] * QS_NSA, v[3] * QS_NSA); o.z = pk2(v[4] * QS_NSA, v[5] * QS_NSA); o.w = pk2(v[6] * QS_NSA, v[7] * QS_NSA);
                *(v4u*)(QN + (size_t)m * 512 + base) = o;
            }
#pragma unroll
            for (int it = 0; it < 2; ++it) {
                const int ch = lane + 64 * it;
                if (ch < 96) {
                    const int seg = ch >> 4, w = ch & 15, g = w >> 3, d0 = 8 * (w & 7), base = 512 + 128 * seg + 64 * g + d0; float v[8];
#pragma unroll
                    for (int e = 0; e < 8; ++e) v[e] = bf2f(hb[base + e]);
                    if ((seg & 1) == 0 && d0 < 16) {
#pragma unroll
                        for (int e = 0; e < 8; ++e) { const float c_ = CS8[t * 16 + e], s_ = CS8[t * 16 + 8 + e]; const float pr = bf2f(hb[base + e + (d0 == 0 ? 8 : -8)]); v[e] = (d0 == 0) ? v[e] * c_ - pr * s_ : v[e] * c_ + pr * s_; }
                    }
                    v4u o; o.x = pk2(v[0], v[1]); o.y = pk2(v[2], v[3]); o.z = pk2(v[4], v[5]); o.w = pk2(v[6], v[7]);
                    *(v4u*)(KV6 + (size_t)seg * KV6_SEG + ((size_t)(b * 2 + g) * T + t) * 64 + d0) = o;
                }
            }
            if (lane < 24) GATES[(size_t)m * 24 + lane] = 1.f / (1.f + expf(-bf2f(hb[1280 + lane])));
            {
                float xv[6]; float ss = 0.f;
#pragma unroll
                for (int j = 0; j < 3; ++j) { xv[2 * j] = bf2f(hb[1304 + 2 * lane + 128 * j]); xv[2 * j + 1] = bf2f(hb[1304 + 2 * lane + 128 * j + 1]); ss += xv[2 * j] * xv[2 * j] + xv[2 * j + 1] * xv[2 * j + 1]; }
                const float r = 1.f / sqrtf(wave_sum(ss) * (1.f / 384.f) + LN_EPS);
#pragma unroll
                for (int j = 0; j < 3; ++j) { const int i = 2 * lane + 128 * j; *(unsigned*)(CQN + (size_t)m * 384 + i) = pk2(xv[2 * j] * r * ap->in[16][i], xv[2 * j + 1] * r * ap->in[16][i + 1]); }
            }
            {
                float xv[4]; float ss = 0.f;
#pragma unroll
                for (int j = 0; j < 2; ++j) { xv[2 * j] = bf2f(hb[1688 + 2 * lane + 128 * j]); xv[2 * j + 1] = bf2f(hb[1688 + 2 * lane + 128 * j + 1]); ss += xv[2 * j] * xv[2 * j] + xv[2 * j + 1] * xv[2 * j + 1]; }
                const float r = 1.f / sqrtf(wave_sum(ss) * (1.f / 256.f) + LN_EPS);
#pragma unroll
                for (int j = 0; j < 2; ++j) { const int i = 2 * lane + 128 * j; *(unsigned*)(CKVN + (size_t)m * 256 + i) = pk2(xv[2 * j] * r * ap->in[17][i], xv[2 * j + 1] * r * ap->in[17][i + 1]); }
            }
            if (lane < 32) {
                const float xs = bf2f(hb[1944 + lane]), pr = bf2f(hb[1944 + (lane ^ 16)]); const float c_ = CS16[t * 32 + (lane & 15)], s_ = CS16[t * 32 + 16 + (lane & 15)];
                const float r = (lane < 16) ? xs * c_ - pr * s_ : xs * c_ + pr * s_;
                KR[(size_t)m * 32 + lane] = (bf16)f2bf(r);
            }
            LDS_WAIT(); asm volatile("" ::: "memory");
        }
    }
    PH_END
    PH_BEGIN
#if !defined(ONLY_G) || ONLY_G == 4
    { int Kq = 384; asm volatile("" : "+s"(Kq)); pg8::Gemm g{CQN, Wuq, M, 768, Kq}; pg8::StaticOrder S; S.init(M, 768, G, bx); pg8::EpiQmla E{QMLA, CS16};
      pg8::gemm_phase<pg8::EpiQmla, pg8::StaticOrder, true, true>(lds, g, S, E); }
#endif
#if !defined(ONLY_G) || ONLY_G == 5
    { int Kq = 1024; asm volatile("" : "+s"(Kq)); pg8::Gemm g{KV6 + 0 * KV6_SEG, W1k, 2048, 512, Kq}; pg8::StaticOrder S; S.init(2048, 512, G, (bx + G - 192 % G) % G); pg8::EpiF32 E{YK, 512};
      pg8::gemm_phase<pg8::EpiF32, pg8::StaticOrder, true, true>(lds, g, S, E); }
#endif
#if !defined(ONLY_G) || ONLY_G == 6
    { int Kq = 1024; asm volatile("" : "+s"(Kq)); pg8::Gemm g{KV6 + 1 * KV6_SEG, W1v, 2048, 512, Kq}; pg8::StaticOrder S; S.init(2048, 512, G, (bx + G - 208 % G) % G); pg8::EpiF32 E{YV, 512};
      pg8::gemm_phase<pg8::EpiF32, pg8::StaticOrder, true, true>(lds, g, S, E); }
#endif
#if !defined(ONLY_G) || ONLY_G == 7
    { int Kq = 256; asm volatile("" : "+s"(Kq)); pg8::Gemm g{CKVN, Wukv, M, 1024, Kq}; pg8::StaticOrder S; S.init(M, 1024, G, bx); pg8::EpiBf16<0> E{KVMLA, 1024, nullptr, 0, 0, 1.f};
      pg8::gemm_phase<pg8::EpiBf16<0>, pg8::StaticOrder, true, true>(lds, g, S, E); }
#endif
    PH_END
    PH_BEGIN
    {
        LAS float* hbuf = (LAS float*)(lds + wave * 1024);
        for (int idx = gw; idx < 2 * 4 * 512; idx += NGW) {
            const int kv = idx >> 11, bg = (idx >> 9) & 3, n = idx & 511;
            bf16* dst = (kv ? VCMP : KCMP) + ((size_t)bg * 512 + n) * 64;
            if (n == 511) { dst[lane] = 0; continue; }
            const float* Y = kv ? YV : YK; const float* pb = posb + kv * 256; const float* w2 = ap->in[kv ? 15 : 12];
#pragma unroll
            for (int i = 0; i < 4; ++i) { const int j = lane + 64 * i; const float p = Y[((size_t)bg * 512 + n) * 512 + j] + Y[((size_t)bg * 512 + n + 1) * 512 + 256 + j] + pb[j];
                const float y = 0.7978845608028654f * (p + 0.044715f * p * p * p); const float th = 1.f - 2.f / (expf(2.f * y) + 1.f); hbuf[j] = 0.5f * p * (1.f + th); }
            LDS_WAIT();
            float acc = 0.f;
#pragma unroll 8
            for (int j = 0; j < 256; ++j) acc += hbuf[j] * w2[j * 64 + lane];
            dst[lane] = (bf16)f2bf(acc);
            LDS_WAIT(); asm volatile("" ::: "memory");
        }
    }
    PH_END
    PH_BEGIN
    {
#ifndef NO_ATT
        for (int pi = bx; pi < 256; pi += G) {
#ifndef REP_MLA
#define REP_MLA 1
#endif
#ifndef REP_NSA
#define REP_NSA 1
#endif
#pragma nounroll
            for (int rep = 0; rep < 2 * REP_MLA; ++rep) {
                unsigned char* w2 = ws; asm volatile("" : "+s"(w2));
                const att::MlaPtrs MP{(const bf16*)(w2 + WS_QMLA), (const bf16*)(w2 + WS_KVMLA), (const bf16*)(w2 + WS_KR), (bf16*)(w2 + WS_U)};
                const int bh = pi >> 4, s = pi & 15; att::mla_item(lds, MP, bh >> 3, bh & 7, (rep & 1) ? s : 31 - s, tid);
            }
#ifndef NO_NSA
#pragma nounroll
            for (int rep = 0; rep < 2 * REP_NSA; ++rep) {
                unsigned char* w2 = ws; asm volatile("" : "+s"(w2));
                const att::NsaPtrs NP{(const bf16*)(w2 + WS_QN), (const bf16*)(w2 + WS_KV6), (const bf16*)(w2 + WS_KCMP), (const bf16*)(w2 + WS_VCMP), (const float*)(w2 + WS_GATES), (bf16*)(w2 + WS_U)};
                const int bg = pi >> 6, s = pi & 63; att::nsa_item(lds, NP, bg >> 1, bg & 1, (rep & 1) ? s : 127 - s, tid);
            }
#endif
        }
#endif
    }
    PH_END
    PH_BEGIN
#if !defined(ONLY_G) || ONLY_G == 8
    { int Kq = D; asm volatile("" : "+s"(Kq)); pg8::Gemm g{U, Wout, M, D, Kq}; pg8::StaticOrder S; S.init(M, D, G, bx); pg8::EpiResid E{XOUT, XOUT, mod + 5 * D, 1.0f};
      pg8::gemm_phase<pg8::EpiResid, pg8::StaticOrder, true, true>(lds, g, S, E); }
#endif
    PH_END
    PH_BEGIN
    row_pass<true, true>(XOUT, XOUT, ap->in[4] + 1 * D, ap->in[5] + 1 * D, mod, 6 * D, 7 * D, U, gw, NGW, lane);
    PH_END
    PH_BEGIN
#if !defined(ONLY_G) || ONLY_G == 9
    { int Kq = D; asm volatile("" : "+s"(Kq)); pg8::Gemm g{U, Wgu2, M, 2 * FF, Kq}; pg8::StaticOrder S; S.init(M, 2 * FF, G, bx); pg8::EpiSwiglu E{HFF, FF};
      pg8::gemm_phase<pg8::EpiSwiglu, pg8::StaticOrder, true, true>(lds, g, S, E); }
#endif
    PH_END
    PH_BEGIN
#if !defined(ONLY_G) || ONLY_G == 10
    { int Kq = FF; asm volatile("" : "+s"(Kq)); pg8::Gemm g{HFF, Wd2, M, D, Kq}; pg8::StaticOrder S; S.init(M, D, G, bx); pg8::EpiResid E{XOUT, XOUT, mod + 8 * D, 0.5f};
      pg8::gemm_phase<pg8::EpiResid, pg8::StaticOrder, true, true>(lds, g, S, E); }
#endif
    PH_END
#ifdef REP_SYNC
    for (int r_ = 0; r_ < REP_SYNC; ++r_) { PH_BEGIN PH_END }
#endif
    PH_BEGIN
    row_pass<true, false>(XOUT, XOUT, ap->in[4] + 2 * D, ap->in[5] + 2 * D, mod, 0, 0, U, gw, NGW, lane);
    }
}

#undef PH_BEGIN
#undef PH_END
#undef mod
#undef posb
#undef CS8
#undef CS16
#undef Wgu1
#undef Wd1
#undef Wgu2
#undef Wd2
#undef Win
#undef Wout
#undef Wuq
#undef Wukv
#undef W1k
#undef W1v
#undef KCMP
#undef VCMP
#undef YK
#undef YV
#undef GATES
#undef KR
#undef U
#undef HFF
#undef H
#undef QMLA
#undef KVMLA
#undef QN
#undef KV6
#undef CQN
#undef CKVN
#undef XIN
#undef XOUT

extern "C" void kernel_launch(void* const* d_in, const int* in_sizes, int n_in, void* d_out, int out_size, void* d_ws, size_t ws_size, hipStream_t stream) {
    static int grid = 0;
    if (grid == 0) {
        if (n_in != 24 || ws_size < WS_END) { fprintf(stderr, "kernel_launch: unexpected inputs (n_in %d, ws %zu)\n", n_in, ws_size); grid = -1; return; }
        int dev = 0, cus = 0, per_cu = 0;
        (void)hipGetDevice(&dev); (void)hipDeviceGetAttribute(&cus, hipDeviceAttributeMultiprocessorCount, dev);
        (void)hipFuncSetAttribute((const void*)mega_fwd, hipFuncAttributeMaxDynamicSharedMemorySize, LDS_BYTES);
        if (hipOccupancyMaxActiveBlocksPerMultiprocessor(&per_cu, (const void*)mega_fwd, NTHREADS, LDS_BYTES) != hipSuccess || per_cu < 1) { fprintf(stderr, "kernel_launch: occupancy query says %d\n", per_cu); per_cu = 1; }
        (void)hipGetLastError();
        grid = cus * per_cu;
    }
    if (grid < 0) return;
    Args a{};
    for (int i = 0; i < 24; ++i) a.in[i] = (const float*)d_in[i];
    a.out = (float*)d_out; a.ws = (unsigned char*)d_ws;
    const double two_pi = 6.283185307179586476925286766559;
    for (int i = 0; i < 8; ++i) a.inv8[i] = pow(500000.0, -(double)i / 8.0) / two_pi;
    for (int i = 0; i < 16; ++i) a.inv16[i] = pow(500000.0, -(double)i / 16.0) / two_pi;
    if (hipMemsetAsync((unsigned char*)d_ws + WS_CTL, 0, CTL_BYTES, stream) != hipSuccess) { fprintf(stderr, "kernel_launch: memset failed\n"); return; }
    void* args[] = {&a};
    hipError_t e = hipLaunchCooperativeKernel((const void*)mega_fwd, dim3(grid), dim3(NTHREADS), args, LDS_BYTES, stream);
    if (e != hipSuccess) fprintf(stderr, "cooperative launch failed: %s (grid %d)\n", hipGetErrorString(e), grid);
}
```

```cpp
#include <hip/hip_runtime.h>
#include <hip/hip_cooperative_groups.h>
#include <cstdio>
#include <cstdint>
#include <cmath>
namespace cg = cooperative_groups;
namespace pg8 {
#define PG8_LAS __attribute__((address_space(3)))
typedef unsigned short bf16_t;
typedef short bf16x8 __attribute__((ext_vector_type(8)));
typedef float f32x4 __attribute__((ext_vector_type(4)));
typedef unsigned u32x4 __attribute__((ext_vector_type(4)));
constexpr int BM = 256, BK = 64, HALF = 128, HTB = HALF * BK * 2  , STAGE_BYTES = 8 * HTB, NXCD = 8, WGM = 8;

__host__ __device__ __forceinline__ int lds_byte(int r, int c) { const int st = (r >> 4) * 2 + (c >> 5), rr = r & 15, cc = c & 31, ob = rr * 64 + cc * 2; return st * 1024 + (ob ^ (((ob >> 9) & 1) << 5)); }
__host__ __device__ __forceinline__ void stage_rc(int b, int& R, int& C) { const int st = b / 1024, sb = b % 1024, swz = sb ^ (((sb >> 9) & 1) << 5); R = (st >> 1) * 16 + swz / 64; C = (st & 1) * 32 + (swz % 64) / 2; }
__host__ __device__ __forceinline__ int perm32(int rho) { const int n = rho >> 4, i = rho & 15; return 8 * (i >> 2) + 4 * n + (i & 3); }

struct Unit { int pm, pn; };
struct Gemm { const bf16_t* A; const bf16_t* Bt; int M, N, K; };

struct StaticOrder {
    int nM, nN, nwg, G, c;
    __host__ __device__ void init(int M, int N, int G_, int c_) { nM = M / BM; nN = N / BM; nwg = nM * nN; G = G_; c = c_; }
    __host__ __device__ bool next(int i, Unit& u) const {
        const long L = (long)i * G + c; if (L >= nwg) return false;
        int wgid = (int)L; { const int q = nwg / NXCD, r = nwg % NXCD, xcd = wgid % NXCD, off = wgid / NXCD; wgid = (xcd < r ? xcd * (q + 1) : r * (q + 1) + (xcd - r) * q) + off; }
        const int nig = WGM * nN, gid = wgid / nig, fm = gid * WGM, gsz = (nM - fm) < WGM ? (nM - fm) : WGM;
        u.pm = fm + ((wgid % nig) % gsz); u.pn = (wgid % nig) / gsz; return true;
    }
    __device__ __forceinline__ void a_ready(const Unit&) const {}
    __device__ __forceinline__ void done(const Unit&) const {}
};

__device__ __forceinline__ unsigned cvt_pk_bf16(float lo, float hi) { unsigned r; asm volatile("v_cvt_pk_bf16_f32 %0, %1, %2" : "=v"(r) : "v"(lo), "v"(hi)); return r; }
typedef float f32x2 __attribute__((ext_vector_type(2)));
__device__ __forceinline__ f32x2 gelu_pk(f32x2 v) {
    const f32x2 av = __builtin_elementwise_abs(v), d = av * 0.2316418882f + 1.0f;
    f32x2 t; t.x = __builtin_amdgcn_rcpf(d.x); t.y = __builtin_amdgcn_rcpf(d.y);
    f32x2 q = t * 0.5307027145f + (-0.7265760135f); q = q * t + 0.7107068705f; q = q * t + (-0.142248368f); q = q * t + 0.127414796f; q = q * t;
    const f32x2 s = (v * v) * (-0.72134752044f);
    f32x2 e; e.x = __builtin_amdgcn_exp2f(s.x); e.y = __builtin_amdgcn_exp2f(s.y);
    const f32x2 m = v * (q * e), r = v - m;
    f32x2 o; o.x = v.x < 0.f ? m.x : r.x; o.y = v.y < 0.f ? m.y : r.y; return o;
}

template <int ACT  > struct EpiBf16 {
    static constexpr bool PERM = true, AFTER_DRAIN = false; static_assert(ACT == 0 || ACT == 1, "EpiBf16: ACT is 0 (none) or 1 (gelu_pk)");
    bf16_t* O; int ldc; const float* bias; int split_cols; size_t split_stride; float scale0;
    __device__ __forceinline__ void operator()(const f32x4 (&acc)[2][2][4][2], const Unit& u, int wr, int wc, int fr, int fq) const {
        const int row0 = u.pm * BM + wr * 64 + fr; int colt = u.pn * BM; bf16_t* base = O;
        float sc = 1.f; if (split_cols) { const int t = colt / split_cols; base += (size_t)t * split_stride; colt -= t * split_cols; if (t == 0) sc = scale0; }
        const int col0 = colt + wc * 32 + 8 * fq, bcol0 = u.pn * BM + wc * 32 + 8 * fq;
        f32x4 bv[2][2];
#pragma unroll
        for (int bj = 0; bj < 2; ++bj)
#pragma unroll
            for (int n = 0; n < 2; ++n) bv[bj][n] = bias ? *(const f32x4*)(bias + bcol0 + bj * HALF + 4 * n) : (f32x4){0.f, 0.f, 0.f, 0.f};
#pragma unroll
        for (int ai = 0; ai < 2; ++ai)
#pragma unroll
            for (int m = 0; m < 4; ++m) { bf16_t* rowp = base + (size_t)(row0 + ai * HALF + m * 16) * ldc + col0;
#pragma unroll
                for (int bj = 0; bj < 2; ++bj) { f32x4 v0 = acc[ai][bj][m][0] + bv[bj][0], v1 = acc[ai][bj][m][1] + bv[bj][1];
                    if (ACT == 1) { f32x2 a = gelu_pk((f32x2){v0[0], v0[1]}), b = gelu_pk((f32x2){v0[2], v0[3]}), c = gelu_pk((f32x2){v1[0], v1[1]}), d = gelu_pk((f32x2){v1[2], v1[3]});
                        v0 = (f32x4){a.x, a.y, b.x, b.y}; v1 = (f32x4){c.x, c.y, d.x, d.y}; }
                    v0 = v0 * sc; v1 = v1 * sc; u32x4 w; w.x = cvt_pk_bf16(v0[0], v0[1]); w.y = cvt_pk_bf16(v0[2], v0[3]); w.z = cvt_pk_bf16(v1[0], v1[1]); w.w = cvt_pk_bf16(v1[2], v1[3]);
                    *(u32x4*)(rowp + bj * HALF) = w; } }
    }
};
template <class Epi, class Sched, bool ALIGN_EPI = false, bool SP2 = false>
__device__ __forceinline__ void gemm_phase(PG8_LAS unsigned char* lds, const Gemm g, const Sched& S, const Epi& E) {
    const int tid = threadIdx.x, wid = __builtin_amdgcn_readfirstlane(tid >> 6), lane = tid & 63, wr = wid >> 2, wc = wid & 3, fr = lane & 15, fq = lane >> 4;
    const int K = g.K, nt = K / BK;
    unsigned voffA[2], voffB[2];
#pragma unroll
    for (int i = 0; i < 2; ++i) { int R, C; stage_rc(tid * 16 + i * 8192, R, C); const int Rb = Epi::PERM ? ((R & ~31) + perm32(R & 31)) : R;
        voffA[i] = (unsigned)(R * K + C) * 2u; voffB[i] = (unsigned)(Rb * K + C) * 2u; }
    const size_t kstep = (size_t)(BK * 2);
    const size_t hstep = (size_t)HALF * K * 2;
    const size_t tstep = 2 * hstep;
    const unsigned ldsw = (unsigned)wid * 1024u;
    const int aoff = lds_byte(wr * 64 + fr, fq * 8), boff = lds_byte(wc * 32 + fr, fq * 8);
#define PG8_SA(b, h) (((b) * 2 + (h)) * HTB)
#define PG8_SB(b, h) ((4 + (b) * 2 + (h)) * HTB)
#define PG8_STAGE(bufoff, gbase, voff) do { _Pragma("unroll") for (int _i = 0; _i < 2; ++_i) \
        __builtin_amdgcn_global_load_lds((const unsigned*)((const char*)(gbase) + (voff)[_i]), (PG8_LAS unsigned*)(lds + (bufoff) + ldsw + _i * 8192), 16, 0, 0); } while (0)
#define PG8_LDA(dst, b, h) do { _Pragma("unroll") for (int m = 0; m < 4; ++m) _Pragma("unroll") for (int k = 0; k < 2; ++k) dst[m][k] = *(const PG8_LAS bf16x8*)(lds + PG8_SA(b, h) + aoff + m * 2048 + k * 1024); } while (0)
#define PG8_LDB(dst, b, h) do { _Pragma("unroll") for (int n = 0; n < 2; ++n) _Pragma("unroll") for (int k = 0; k < 2; ++k) dst[n][k] = *(const PG8_LAS bf16x8*)(lds + PG8_SB(b, h) + boff + n * 2048 + k * 1024); } while (0)
#define PG8_MMA(ai, bj, At, Bt) do { __builtin_amdgcn_s_setprio(1); _Pragma("unroll") for (int m = 0; m < 4; ++m) _Pragma("unroll") for (int n = 0; n < 2; ++n) _Pragma("unroll") for (int k = 0; k < 2; ++k) \
        acc[ai][bj][m][n] = __builtin_amdgcn_mfma_f32_16x16x32_bf16(Bt[n][k], At[m][k], acc[ai][bj][m][n], 0, 0, 0); __builtin_amdgcn_s_setprio(0); } while (0)
#define PG8_WAIT_V(n) asm volatile("s_waitcnt vmcnt(" #n ")" ::: "memory")
#define PG8_WAIT_L(n) asm volatile("s_waitcnt lgkmcnt(" #n ")" ::: "memory")
#define PG8_BAR __builtin_amdgcn_s_barrier()
#define PG8_SCHED __builtin_amdgcn_sched_barrier(0)
    Unit cur, nxt; int ui = 0;
    if (!S.next(0, cur)) return;
    f32x4 acc[2][2][4][2];
#pragma unroll
    for (int a = 0; a < 2; ++a)
#pragma unroll
        for (int b = 0; b < 2; ++b)
#pragma unroll
            for (int m = 0; m < 4; ++m)
#pragma unroll
                for (int n = 0; n < 2; ++n) acc[a][b][m][n] = (f32x4){0.f, 0.f, 0.f, 0.f};
    bf16x8 At[4][2], B0[2][2], B1[2][2];
    const char* cA = (const char*)g.A + (size_t)cur.pm * tstep; const char* cB = (const char*)g.Bt + (size_t)cur.pn * tstep;
    S.a_ready(cur);
    if constexpr (SP2) {
        PG8_STAGE(PG8_SB(0, 0), cB, voffB); PG8_STAGE(PG8_SB(0, 1), cB + hstep, voffB); PG8_STAGE(PG8_SA(0, 0), cA, voffA); PG8_STAGE(PG8_SA(0, 1), cA + hstep, voffA);
        if (wr == 1) PG8_BAR;
        PG8_WAIT_V(2); PG8_BAR;
        PG8_STAGE(PG8_SB(1, 0), cB + kstep, voffB); PG8_STAGE(PG8_SA(1, 0), cA + kstep, voffA); PG8_STAGE(PG8_SB(1, 1), cB + hstep + kstep, voffB);
        PG8_WAIT_V(6); PG8_BAR;
    } else {
        PG8_STAGE(PG8_SB(0, 0), cB, voffB); PG8_STAGE(PG8_SA(0, 0), cA, voffA); PG8_STAGE(PG8_SB(0, 1), cB + hstep, voffB); PG8_STAGE(PG8_SA(0, 1), cA + hstep, voffA);
        if (wr == 1) PG8_BAR;
        PG8_WAIT_V(4); PG8_BAR;
        PG8_STAGE(PG8_SB(1, 0), cB + kstep, voffB); PG8_STAGE(PG8_SA(1, 0), cA + kstep, voffA); PG8_STAGE(PG8_SB(1, 1), cB + hstep + kstep, voffB);
        PG8_WAIT_V(6); PG8_BAR;
    }
    for (;;) {
        const bool has_next = S.next(ui + 1, nxt);
        const char* nA = has_next ? (const char*)g.A + (size_t)nxt.pm * tstep : cA; const char* nB = has_next ? (const char*)g.Bt + (size_t)nxt.pn * tstep : cB;
        for (int t = 0; t < nt; t += 2) {
            const bool last = (t == nt - 2);
            const char* a1 = cA + (size_t)(t + 1) * kstep;
            const char* a2 = last ? nA : cA + (size_t)(t + 2) * kstep; const char* b2 = last ? nB : cB + (size_t)(t + 2) * kstep;
            const char* a3 = a2 + kstep; const char* b3 = b2 + kstep;
            if (last && has_next) S.a_ready(nxt);
            if constexpr (SP2) {
            PG8_LDB(B0, 0, 0); PG8_LDB(B1, 0, 1); PG8_SCHED; PG8_LDA(At, 0, 0); PG8_STAGE(PG8_SA(1, 1), a1 + hstep, voffA);
            PG8_WAIT_V(8); PG8_WAIT_L(0); PG8_BAR; PG8_MMA(0, 0, At, B0); PG8_MMA(0, 1, At, B1); PG8_BAR; PG8_SCHED;
            PG8_LDA(At, 0, 1); PG8_STAGE(PG8_SB(0, 0), b2, voffB); PG8_STAGE(PG8_SB(0, 1), b2 + hstep, voffB); PG8_STAGE(PG8_SA(0, 0), a2, voffA);
            PG8_WAIT_V(8); PG8_WAIT_L(0); PG8_BAR; PG8_MMA(1, 0, At, B0); PG8_MMA(1, 1, At, B1); PG8_BAR; PG8_SCHED;
            PG8_LDB(B0, 1, 0); PG8_LDB(B1, 1, 1); PG8_SCHED; PG8_LDA(At, 1, 0); PG8_STAGE(PG8_SA(0, 1), a2 + hstep, voffA);
            PG8_WAIT_V(8); PG8_WAIT_L(0); PG8_BAR; PG8_MMA(0, 0, At, B0); PG8_MMA(0, 1, At, B1); PG8_BAR; PG8_SCHED;
            PG8_LDA(At, 1, 1); PG8_STAGE(PG8_SB(1, 0), b3, voffB); PG8_STAGE(PG8_SB(1, 1), b3 + hstep, voffB); PG8_STAGE(PG8_SA(1, 0), a3, voffA);
            PG8_WAIT_V(8); PG8_WAIT_L(0); PG8_BAR; PG8_MMA(1, 0, At, B0); PG8_MMA(1, 1, At, B1); PG8_BAR; PG8_SCHED;
            } else {
            PG8_LDB(B0, 0, 0); PG8_SCHED; PG8_LDA(At, 0, 0); PG8_STAGE(PG8_SA(1, 1), a1 + hstep, voffA);
            PG8_WAIT_L(8); PG8_BAR; PG8_WAIT_L(0); PG8_MMA(0, 0, At, B0); PG8_BAR; PG8_SCHED;
            PG8_LDB(B1, 0, 1); PG8_STAGE(PG8_SB(0, 0), b2, voffB);
            PG8_BAR; PG8_WAIT_L(0); PG8_MMA(0, 1, At, B1); PG8_BAR;
            PG8_LDA(At, 0, 1); PG8_STAGE(PG8_SA(0, 0), a2, voffA);
            PG8_BAR; PG8_WAIT_L(0); PG8_MMA(1, 0, At, B0); PG8_BAR; PG8_SCHED;
            PG8_STAGE(PG8_SB(0, 1), b2 + hstep, voffB);
            PG8_WAIT_V(6); PG8_BAR; PG8_MMA(1, 1, At, B1); PG8_BAR;
            PG8_LDB(B0, 1, 0); PG8_SCHED; PG8_LDA(At, 1, 0); PG8_STAGE(PG8_SA(0, 1), a2 + hstep, voffA);
            PG8_WAIT_L(8); PG8_BAR; PG8_WAIT_L(0); PG8_MMA(0, 0, At, B0); PG8_BAR; PG8_SCHED;
            PG8_LDB(B1, 1, 1); PG8_STAGE(PG8_SB(1, 0), b3, voffB);
            PG8_BAR; PG8_WAIT_L(0); PG8_MMA(0, 1, At, B1); PG8_BAR;
            PG8_LDA(At, 1, 1); PG8_STAGE(PG8_SA(1, 0), a3, voffA);
            PG8_BAR; PG8_WAIT_L(0); PG8_MMA(1, 0, At, B0); PG8_BAR; PG8_SCHED;
            PG8_STAGE(PG8_SB(1, 1), b3 + hstep, voffB);
            PG8_WAIT_V(6); PG8_BAR; PG8_MMA(1, 1, At, B1); PG8_BAR;
            }
        }
        if constexpr (ALIGN_EPI) { if (wr == 0) PG8_BAR; }
        if constexpr (!Epi::AFTER_DRAIN) { E(acc, cur, wr, wc, fr, fq); S.done(cur); }
        if (!has_next) break;
#pragma unroll
        for (int a = 0; a < 2; ++a)
#pragma unroll
            for (int b = 0; b < 2; ++b)
#pragma unroll
                for (int m = 0; m < 4; ++m)
#pragma unroll
                    for (int n = 0; n < 2; ++n) acc[a][b][m][n] = (f32x4){0.f, 0.f, 0.f, 0.f};
        cur = nxt; cA = nA; cB = nB; ++ui;
        if constexpr (ALIGN_EPI) { if (wr == 1) PG8_BAR; }
    }
    PG8_WAIT_V(0);
    if constexpr (!ALIGN_EPI) { if (wr == 0) PG8_BAR; }
    PG8_BAR;
    if constexpr (Epi::AFTER_DRAIN) { E.fused(acc, cur, wr, wc, fr, fq, lds, wid, lane); S.done(cur); }
#undef PG8_SA
#undef PG8_SB
#undef PG8_STAGE
#undef PG8_LDA
#undef PG8_LDB
#undef PG8_MMA
#undef PG8_WAIT_V
#undef PG8_WAIT_L
#undef PG8_BAR
#undef PG8_SCHED
}
}

#define LAS __attribute__((address_space(3)))
typedef unsigned short bf16;
typedef unsigned v4u __attribute__((ext_vector_type(4)));
typedef unsigned v2u __attribute__((ext_vector_type(2)));
typedef float f32x4 __attribute__((ext_vector_type(4)));
typedef short bf16x8 __attribute__((ext_vector_type(8)));
typedef short s16x4 __attribute__((ext_vector_type(4)));
#define LDS_WAIT() asm volatile("s_waitcnt lgkmcnt(0)" ::: "memory")

constexpr int BATCH = 2, T = 8192, D = 1024, M = BATCH * T, FF = 2816, DIN = 1976, DINP = 2048, NMOD = 9 * D;
constexpr float ALPHA = 1.18920711500272f;
constexpr float LN_EPS = 1e-5f;
constexpr float QS_NSA = 0.125f * 1.4426950408889634f;
constexpr float QS_MLA = 0.10206207261596575f * 1.4426950408889634f;
constexpr int LDS_BYTES = 147456;
constexpr int NTHREADS = 512;

constexpr size_t MiB = 1u << 20;
constexpr size_t WS_CTL = 832 * 1024, CTL_BYTES = 16 * 1024;
constexpr size_t WS_MOD = 0, WS_POSB = 128 * 1024, WS_CS8 = 256 * 1024, WS_CS16 = 57 * MiB;
constexpr size_t WS_WGU1 = 1 * MiB, WS_WD1 = 12 * MiB, WS_WGU2 = 18 * MiB, WS_WD2 = 29 * MiB, WS_WIN = 35 * MiB, WS_WOUT = 39 * MiB, WS_WUQ = 41 * MiB, WS_WUKV = 42 * MiB,
                 WS_W1K = 43 * MiB, WS_W1V = 44 * MiB, WS_KCMP = 45 * MiB, WS_VCMP = 45 * MiB + 512 * 1024, WS_YK = 46 * MiB, WS_YV = 50 * MiB, WS_GATES = 54 * MiB, WS_KR = 56 * MiB,
                 WS_U = 58 * MiB, WS_BIG = 90 * MiB;
constexpr size_t WS_HFF = WS_BIG, WS_H = WS_BIG, WS_QMLA = WS_BIG, WS_KVMLA = WS_BIG + 24 * MiB, WS_QN = WS_BIG + 64 * MiB, WS_KV6 = WS_BIG + 80 * MiB, WS_CQN = WS_BIG + 104 * MiB, WS_CKVN = WS_BIG + 116 * MiB;
constexpr size_t KV6_SEG = (size_t)BATCH * 2 * T * 64;
constexpr size_t WS_END = WS_BIG + 124 * MiB;
static_assert(WS_END <= 256 * MiB, "ws map");

struct Args { const float* in[24]; float* out; unsigned char* ws; double inv8[8]; double inv16[16]; };

__device__ __forceinline__ float wave_sum(float v) {
#pragma unroll
    for (int o = 1; o < 64; o <<= 1) v += __shfl_xor(v, o);
    return v;
}
__device__ __forceinline__ unsigned f2bf(float f) { unsigned u = __builtin_bit_cast(unsigned, f); return (u + 0x7fffu + ((u >> 16) & 1u)) >> 16; }
__device__ __forceinline__ unsigned pk2(float lo, float hi) { return f2bf(lo) | (f2bf(hi) << 16); }
__device__ __forceinline__ float bf2f(unsigned short h) { return __builtin_bit_cast(float, (unsigned)h << 16); }
__device__ __forceinline__ void rope_cs(int pos, double invrev, float& c, float& s) {
    double a = (double)pos * invrev; a -= __builtin_floor(a); const float f = (float)a;
    s = __builtin_amdgcn_sinf(f); c = __builtin_amdgcn_cosf(f);
}

namespace pg8 {
struct EpiSwiglu {
    static constexpr bool PERM = true, AFTER_DRAIN = false;
    bf16_t* O; int ldc;
    __device__ __forceinline__ void operator()(const f32x4 (&acc)[2][2][4][2], const Unit& u, int wr, int wc, int fr, int fq) const {
        const int row0 = u.pm * BM + wr * 64 + fr, col0 = u.pn * 128 + wc * 32 + 8 * fq;
#pragma unroll
        for (int ai = 0; ai < 2; ++ai)
#pragma unroll
            for (int m = 0; m < 4; ++m) {
                bf16_t* rowp = O + (size_t)(row0 + ai * HALF + m * 16) * ldc + col0;
                float h[8];
#pragma unroll
                for (int n = 0; n < 2; ++n)
#pragma unroll
                    for (int e = 0; e < 4; ++e) { const float g = acc[ai][0][m][n][e], up = acc[ai][1][m][n][e]; h[4 * n + e] = g * __builtin_amdgcn_rcpf(1.f + __expf(-g)) * up; }
                u32x4 w; w.x = cvt_pk_bf16(h[0], h[1]); w.y = cvt_pk_bf16(h[2], h[3]); w.z = cvt_pk_bf16(h[4], h[5]); w.w = cvt_pk_bf16(h[6], h[7]);
                *(u32x4*)rowp = w;
            }
    }
};
struct EpiResid {
    static constexpr bool PERM = false, AFTER_DRAIN = false;
    const float* xin; float* out; const float* gate; float coef;
    __device__ __forceinline__ void operator()(const f32x4 (&acc)[2][2][4][2], const Unit& u, int wr, int wc, int fr, int fq) const {
        const int row0 = u.pm * BM + wr * 64 + fr, col0 = u.pn * BM + wc * 32 + 4 * fq;
#pragma unroll
        for (int ai = 0; ai < 2; ++ai)
#pragma unroll
            for (int m = 0; m < 4; ++m) {
                const int row = row0 + ai * HALF + m * 16; const int b = row >> 13;
#pragma unroll
                for (int bj = 0; bj < 2; ++bj)
#pragma unroll
                    for (int n = 0; n < 2; ++n) {
                        const int col = col0 + bj * HALF + n * 16;
                        const f32x4 gv = *(const f32x4*)(gate + (size_t)b * 9216 + col);
                        const f32x4 xv = *(const f32x4*)(xin + (size_t)row * 1024 + col);
                        const f32x4 o = xv * ALPHA + (gv + 1.0f) * coef * acc[ai][bj][m][n];
                        *(f32x4*)(out + (size_t)row * 1024 + col) = o;
                    }
            }
    }
};
struct EpiF32 {
    static constexpr bool PERM = false, AFTER_DRAIN = false;
    float* out; int ldc;
    __device__ __forceinline__ void operator()(const f32x4 (&acc)[2][2][4][2], const Unit& u, int wr, int wc, int fr, int fq) const {
        const int row0 = u.pm * BM + wr * 64 + fr, col0 = u.pn * BM + wc * 32 + 4 * fq;
#pragma unroll
        for (int ai = 0; ai < 2; ++ai)
#pragma unroll
            for (int m = 0; m < 4; ++m)
#pragma unroll
                for (int bj = 0; bj < 2; ++bj)
#pragma unroll
                    for (int n = 0; n < 2; ++n) *(f32x4*)(out + (size_t)(row0 + ai * HALF + m * 16) * ldc + col0 + bj * HALF + n * 16) = acc[ai][bj][m][n];
    }
};
struct EpiQmla {
    static constexpr bool PERM = false, AFTER_DRAIN = false;
    bf16_t* O; const float* cst;
    __device__ __forceinline__ void operator()(const f32x4 (&acc)[2][2][4][2], const Unit& u, int wr, int wc, int fr, int fq) const {
        const int row0 = u.pm * BM + wr * 64 + fr, col0 = u.pn * BM + wc * 32 + 4 * fq;
        if (u.pn < 2) {
#pragma unroll
            for (int ai = 0; ai < 2; ++ai)
#pragma unroll
                for (int m = 0; m < 4; ++m)
#pragma unroll
                    for (int bj = 0; bj < 2; ++bj)
#pragma unroll
                        for (int n = 0; n < 2; ++n) { const f32x4 v = acc[ai][bj][m][n] * QS_MLA; unsigned lo = cvt_pk_bf16(v[0], v[1]), hi = cvt_pk_bf16(v[2], v[3]);
                            unsigned long long w = (unsigned long long)lo | ((unsigned long long)hi << 32);
                            *(unsigned long long*)(O + (size_t)(row0 + ai * HALF + m * 16) * 768 + col0 + bj * HALF + n * 16) = w; }
        } else {
#pragma unroll
            for (int ai = 0; ai < 2; ++ai)
#pragma unroll
                for (int m = 0; m < 4; ++m) {
                    const int row = row0 + ai * HALF + m * 16; const int pos = row & 8191;
                    const f32x4 cs = *(const f32x4*)(cst + (size_t)pos * 32 + 4 * fq), sn = *(const f32x4*)(cst + (size_t)pos * 32 + 16 + 4 * fq);
#pragma unroll
                    for (int bj = 0; bj < 2; ++bj) {
                        const f32x4 x1 = acc[ai][bj][m][0], x2 = acc[ai][bj][m][1];
                        const f32x4 o1 = (x1 * cs - x2 * sn) * QS_MLA, o2 = (x2 * cs + x1 * sn) * QS_MLA;
                        bf16_t* p = O + (size_t)row * 768 + col0 + bj * HALF;
                        *(unsigned long long*)(p) = (unsigned long long)cvt_pk_bf16(o1[0], o1[1]) | ((unsigned long long)cvt_pk_bf16(o1[2], o1[3]) << 32);
                        *(unsigned long long*)(p + 16) = (unsigned long long)cvt_pk_bf16(o2[0], o2[1]) | ((unsigned long long)cvt_pk_bf16(o2[2], o2[3]) << 32);
                    }
                }
        }
    }
};
}

namespace att {
constexpr int OFF_K = 0, OFF_V = 13312, BUFSZ = 22528, OFF_SEL = 2 * BUFSZ, OFF_IMP = OFF_SEL + 1024, OFF_OC = OFF_IMP + 64 * 132 * 4, OFF_END = OFF_OC + 8 * 512 * 16;
static_assert(OFF_END <= 147456 - 64 && OFF_OC % 16 == 0, "attention LDS map");
constexpr int VSTR = 72, ISTR = 132;
enum { CAUSAL = 0, WINDOW = 1, CMP = 2, SEL = 3 };
constexpr float NEG = -1e30f;

template <int DQK> struct Stage { v4u k0, k1, v; };

template <int DQK> __device__ __forceinline__ void stage_load(Stage<DQK>& s, const bf16* K0, int p0, const bf16* K1, int p1, const bf16* V, int pv, int tile, bool withV, int tid) {
    { const int key = tid >> 3, c = tid & 7; s.k0 = *(const v4u*)(K0 + (size_t)(64 * tile + key) * p0 + 8 * c); }
    if (DQK == 96) { if (tid < 256) { const int key = tid >> 2, c = tid & 3; s.k1 = *(const v4u*)(K1 + (size_t)(64 * tile + key) * p1 + 8 * c); } }
    if (withV) { const int w = tid >> 6, ky = tid & 63; s.v = *(const v4u*)(V + (size_t)(64 * tile + ky) * pv + 8 * w); }
}
template <int DQK> __device__ __forceinline__ void stage_store(const Stage<DQK>& s, LAS unsigned char* lds, bool withV, int tid) {
    constexpr int KSTR = DQK + 8;
    { const int key = tid >> 3, c = tid & 7; *(LAS v4u*)(lds + OFF_K + (key * KSTR + 8 * c) * 2) = s.k0; }
    if (DQK == 96) { if (tid < 256) { const int key = tid >> 2, c = tid & 3; *(LAS v4u*)(lds + OFF_K + (key * KSTR + 64 + 8 * c) * 2) = s.k1; } }
    if (withV) { const int w = tid >> 6, ky = tid & 63; LAS unsigned short* vt = (LAS unsigned short*)(lds + OFF_V);
#pragma unroll
        for (int e = 0; e < 8; ++e) vt[(8 * w + e) * VSTR + ky] = (unsigned short)((s.v[e >> 1] >> (16 * (e & 1))) & 0xffffu); }
}

template <int DQK> __device__ __forceinline__ void qk_tile(LAS unsigned char* lds, const bf16x8 (&qf)[DQK / 32], f32x4 (&s)[4], int fr, int fq) {
    constexpr int KSTR = DQK + 8, NKS = DQK / 32;
#pragma unroll
    for (int ss = 0; ss < 4; ++ss) {
        s[ss] = (f32x4){0.f, 0.f, 0.f, 0.f};
#pragma unroll
        for (int ks = 0; ks < NKS; ++ks) {
            const bf16x8 kf = *(const LAS bf16x8*)(lds + OFF_K + ((16 * ss + fr) * KSTR + 32 * ks + 8 * fq) * 2);
            s[ss] = __builtin_amdgcn_mfma_f32_16x16x32_bf16(kf, qf[ks], s[ss], 0, 0, 0);
        }
    }
}
template <int MODE> __device__ __forceinline__ bool key_ok(int kpos, int tpos, bool rowsel) {
    if (MODE == CAUSAL) return kpos <= tpos;
    if (MODE == WINDOW) return kpos <= tpos && kpos + 512 > tpos;
    if (MODE == CMP) return 16 * kpos + 31 <= tpos;
    return rowsel && kpos <= tpos;
}
typedef float f32x2_t __attribute__((ext_vector_type(2))); typedef __bf16 bf16x2_t __attribute__((ext_vector_type(2)));
__device__ __forceinline__ unsigned cvtpk(float lo, float hi) { f32x2_t v = {lo, hi}; bf16x2_t b = __builtin_convertvector(v, bf16x2_t); return __builtin_bit_cast(unsigned, b); }
__device__ __forceinline__ float rows_max(float v) {
    auto a = __builtin_amdgcn_permlane16_swap(__float_as_uint(v), __float_as_uint(v), false, false); v = fmaxf(__uint_as_float(a[0]), __uint_as_float(a[1]));
    auto c = __builtin_amdgcn_permlane32_swap(__float_as_uint(v), __float_as_uint(v), false, false); return fmaxf(__uint_as_float(c[0]), __uint_as_float(c[1]));
}
__device__ __forceinline__ float rows_sum(float v) {
    auto a = __builtin_amdgcn_permlane16_swap(__float_as_uint(v), __float_as_uint(v), false, false); v = __uint_as_float(a[0]) + __uint_as_float(a[1]);
    auto c = __builtin_amdgcn_permlane32_swap(__float_as_uint(v), __float_as_uint(v), false, false); return __uint_as_float(c[0]) + __uint_as_float(c[1]);
}
template <int DQK, int MODE, bool FULL, int I0, int NQ> __device__ __forceinline__ void tile_n(LAS unsigned char* lds, const bf16x8 (&qf)[2][DQK / 32], int kbase, const int (&tpos)[2], const bool (&rowsel)[2],
        float (&m)[2], float (&l)[2], f32x4 (&o)[2][4], int fr, int fq) {
    constexpr int KSTR = DQK + 8, NKS = DQK / 32;
    f32x4 s[NQ][4]; float meff[NQ];
#pragma unroll
    for (int q = 0; q < NQ; ++q) { meff[q] = (m[I0 + q] > -1e29f) ? m[I0 + q] : 0.f; const float c = -meff[q];
#pragma unroll
        for (int ss = 0; ss < 4; ++ss) s[q][ss] = (f32x4){c, c, c, c}; }
#pragma unroll
    for (int ss = 0; ss < 4; ++ss)
#pragma unroll
        for (int ks = 0; ks < NKS; ++ks) {
            const bf16x8 kf = *(const LAS bf16x8*)(lds + OFF_K + ((16 * ss + fr) * KSTR + 32 * ks + 8 * fq) * 2);
#pragma unroll
            for (int q = 0; q < NQ; ++q) s[q][ss] = __builtin_amdgcn_mfma_f32_16x16x32_bf16(kf, qf[I0 + q][ks], s[q][ss], 0, 0, 0);
        }
    bf16x8 pb[NQ][2];
#pragma unroll
    for (int q = 0; q < NQ; ++q) {
        float mx;
        if (FULL) {
            mx = fmaxf(fmaxf(s[q][0][0], s[q][0][1]), fmaxf(s[q][0][2], s[q][0][3]));
#pragma unroll
            for (int ss = 1; ss < 4; ++ss) mx = fmaxf(mx, fmaxf(fmaxf(s[q][ss][0], s[q][ss][1]), fmaxf(s[q][ss][2], s[q][ss][3])));
        } else {
            mx = NEG;
#pragma unroll
            for (int ss = 0; ss < 4; ++ss)
#pragma unroll
                for (int i = 0; i < 4; ++i) { const bool ok = key_ok<MODE>(kbase + 16 * ss + 4 * fq + i, tpos[I0 + q], rowsel[I0 + q]); const float v = ok ? s[q][ss][i] : NEG; s[q][ss][i] = v; mx = fmaxf(mx, v); }
        }
        mx = rows_max(mx);
        const float mo = m[I0 + q];
        const bool need = (mo > -1e29f) ? (mx > 0.f) : (mx > -1e29f);
        if (__any(need ? 1 : 0)) {
            const float delta = need ? mx : 0.f; const float mnew = need ? meff[q] + delta : mo; const float alpha = need ? __builtin_amdgcn_exp2f(mo - mnew) : 1.0f;
            l[I0 + q] *= alpha; m[I0 + q] = mnew;
#pragma unroll
            for (int dt = 0; dt < 4; ++dt) o[I0 + q][dt] = o[I0 + q][dt] * alpha;
#pragma unroll
            for (int ss = 0; ss < 4; ++ss) s[q][ss] = s[q][ss] - delta;
        }
        float rs = 0.f;
#pragma unroll
        for (int ss = 0; ss < 4; ++ss)
#pragma unroll
            for (int i = 0; i < 4; ++i) { const float pe = __builtin_amdgcn_exp2f(s[q][ss][i]); s[q][ss][i] = pe; rs += pe; }
        l[I0 + q] += rs;
#pragma unroll
        for (int j = 0; j < 2; ++j) {
            const v4u w = (v4u){cvtpk(s[q][2 * j][0], s[q][2 * j][1]), cvtpk(s[q][2 * j][2], s[q][2 * j][3]), cvtpk(s[q][2 * j + 1][0], s[q][2 * j + 1][1]), cvtpk(s[q][2 * j + 1][2], s[q][2 * j + 1][3])};
            pb[q][j] = __builtin_bit_cast(bf16x8, w);
        }
    }
#pragma unroll
    for (int dt = 0; dt < 4; ++dt)
#pragma unroll
        for (int j = 0; j < 2; ++j) {
            const LAS unsigned char* vp = lds + OFF_V + ((16 * dt + fr) * VSTR + 32 * j + 4 * fq) * 2;
            const v2u lo = *(const LAS v2u*)vp, hi = *(const LAS v2u*)(vp + 32);
            const v4u w = (v4u){lo.x, lo.y, hi.x, hi.y};
#pragma unroll
            for (int q = 0; q < NQ; ++q) o[I0 + q][dt] = __builtin_amdgcn_mfma_f32_16x16x32_bf16(__builtin_bit_cast(bf16x8, w), pb[q][j], o[I0 + q][dt], 0, 0, 0);
        }
}

template <int DQK, int MODE> __device__ __forceinline__ void attn_pass(LAS unsigned char* lds, const bf16* K0, int p0, const bf16* K1, int p1, const bf16* V, int pv, int tlo, int thi,
        const bf16x8 (&qf)[2][DQK / 32], const int (&tpos)[2], const int (&tok)[2], int wave_tmin, int wave_tmax, f32x4 (&o)[2][4], float (&mfin)[2], float (&linv)[2], int tid, int fr, int fq) {
    asm volatile("" : "+v"(tid)); asm volatile("" : "+s"(K0), "+s"(V)); if (DQK == 96) asm volatile("" : "+s"(K1));
    fr = tid & 15; fq = (tid & 63) >> 4;
    float m[2] = {NEG, NEG}, l[2] = {0.f, 0.f};
#pragma unroll
    for (int i = 0; i < 2; ++i)
#pragma unroll
        for (int dt = 0; dt < 4; ++dt) o[i][dt] = (f32x4){0.f, 0.f, 0.f, 0.f};
    Stage<DQK> st;
    stage_load<DQK>(st, K0, p0, K1, p1, V, pv, tlo, true, tid);
    stage_store<DQK>(st, lds, true, tid);
    __syncthreads();
    for (int t = tlo; t <= thi; ++t) {
        LAS unsigned char* buf = lds + ((t - tlo) & 1) * BUFSZ;
        if (t < thi) stage_load<DQK>(st, K0, p0, K1, p1, V, pv, t + 1, true, tid);
        const int kbase = 64 * t;
        const bool skip = (MODE == CMP) ? (16 * kbase + 31 > wave_tmax) : (kbase > wave_tmax);
        if (!skip) {
            bool full = (MODE == CMP) ? (16 * (kbase + 63) + 31 <= wave_tmin) : (kbase + 63 <= wave_tmin);
            if (MODE == WINDOW) full = full && (kbase + 512 > wave_tmax);
            bool rowsel[2] = {true, true}; bool n0 = true, n1 = true;
            if (MODE == SEL) {
#pragma unroll
                for (int i = 0; i < 2; ++i) { const unsigned w = ((const LAS unsigned*)(lds + OFF_SEL))[tok[i] * 4 + (t >> 5)]; rowsel[i] = ((w >> (t & 31)) & 1u) != 0u; }
                n0 = __any(rowsel[0] ? 1 : 0) != 0; n1 = __any(rowsel[1] ? 1 : 0) != 0;
                full = full && (__all((rowsel[0] && rowsel[1]) ? 1 : 0) != 0);
            }
            if (n0 && n1) { if (full) tile_n<DQK, MODE, true, 0, 2>(buf, qf, kbase, tpos, rowsel, m, l, o, fr, fq); else tile_n<DQK, MODE, false, 0, 2>(buf, qf, kbase, tpos, rowsel, m, l, o, fr, fq); }
            else if (MODE == SEL) { if (n0) tile_n<DQK, MODE, false, 0, 1>(buf, qf, kbase, tpos, rowsel, m, l, o, fr, fq); else if (n1) tile_n<DQK, MODE, false, 1, 1>(buf, qf, kbase, tpos, rowsel, m, l, o, fr, fq); }
        }
        if (t < thi) stage_store<DQK>(st, lds + (((t - tlo) & 1) ^ 1) * BUFSZ, true, tid);
        __syncthreads();
    }
#pragma unroll
    for (int i = 0; i < 2; ++i) {
        const float lt = rows_sum(l[i]);
        const float iv = lt > 0.f ? 1.0f / lt : 0.f;
        mfin[i] = m[i]; linv[i] = iv;
#pragma unroll
        for (int dt = 0; dt < 4; ++dt) o[i][dt] = o[i][dt] * iv;
    }
}

struct NsaPtrs { const bf16 *QN, *KV6, *KCMP, *VCMP; const float* GATES; bf16* OCAT; };

__device__ __forceinline__ void nsa_load_q(const bf16* QN, int b, int g, int tid, int t0, bf16x8 (&qf)[2][2]) {
    asm volatile("" : "+v"(tid)); asm volatile("" : "+s"(QN));
    const int wave = tid >> 6, fr = tid & 15, fq = (tid & 63) >> 4, hh = fr >> 2;
#pragma unroll
    for (int i = 0; i < 2; ++i) {
        const size_t mrow = (size_t)b * T + t0 + 8 * wave + 4 * i + (fr & 3);
        const bf16* qrow = QN + mrow * 512 + (g * 4 + hh) * 64;
#pragma unroll
        for (int ks = 0; ks < 2; ++ks) qf[i][ks] = *(const bf16x8*)(qrow + 32 * ks + 8 * fq);
    }
}
__device__ __forceinline__ void nsa_item(LAS unsigned char* lds, const NsaPtrs& P, int b, int g, int qb, int tid) {
    const int wave = tid >> 6, lane = tid & 63, fr = lane & 15, fq = lane >> 4, hh = fr >> 2;
    const int t0 = 64 * qb; const size_t bg = (size_t)(b * 2 + g);
    int tpos[2], tok[2];
#pragma unroll
    for (int i = 0; i < 2; ++i) { tok[i] = 8 * wave + 4 * i + (fr & 3); tpos[i] = t0 + tok[i]; }
    const int wave_tmin = t0 + 8 * wave, wave_tmax = t0 + 8 * wave + 7;
    LAS float* imp = (LAS float*)(lds + OFF_IMP);
    LAS f32x4* ocl = (LAS f32x4*)(lds + OFF_OC);
    for (int idx = tid; idx < 64 * ISTR; idx += NTHREADS) imp[idx] = 0.f;
    bf16x8 qf[2][2]; f32x4 o[2][4]; float mf[2], li[2];
    const bf16* Kc = P.KCMP + bg * 512 * 64; const bf16* Vc = P.VCMP + bg * 512 * 64;
    const int thi_c = ((t0 + 63 - 31) >> 4) >> 6;
    nsa_load_q(P.QN, b, g, tid, t0, qf);
    attn_pass<64, CMP>(lds, Kc, 64, nullptr, 0, Vc, 64, 0, thi_c, qf, tpos, tok, wave_tmin, wave_tmax, o, mf, li, tid, fr, fq);
#pragma unroll
    for (int i = 0; i < 2; ++i) { const float gc = P.GATES[((size_t)b * T + tpos[i]) * 24 + g * 12 + hh * 3 + 0];
#pragma unroll
        for (int dt = 0; dt < 4; ++dt) ocl[(i * 4 + dt) * NTHREADS + tid] = o[i][dt] * gc; }
#ifndef NSA_NO_IMP
    int tid_i = tid; asm volatile("" : "+v"(tid_i)); const int fr_i = tid_i & 15, fq_i = (tid_i & 63) >> 4; asm volatile("" : "+s"(Kc));
    for (int t = 0; t <= thi_c; ++t) {
        __syncthreads();
        { const int key = tid_i >> 3, c = tid_i & 7; *(LAS v4u*)(lds + OFF_K + (key * 72 + 8 * c) * 2) = *(const v4u*)(Kc + (size_t)(64 * t + key) * 64 + 8 * c); }
        __syncthreads();
        if (16 * (64 * t) + 31 > wave_tmax) continue;
#pragma unroll
        for (int i = 0; i < 2; ++i) {
            f32x4 s[4];
            qk_tile<64>(lds, qf[i], s, fr_i, fq_i);
#pragma unroll
            for (int ss = 0; ss < 4; ++ss) {
                float a = 0.f, b3 = 0.f;
#pragma unroll
                for (int e = 0; e < 4; ++e) { const int n = 64 * t + 16 * ss + 4 * fq_i + e; const float p = (16 * n + 31 <= tpos[i]) ? __builtin_amdgcn_exp2f(s[ss][e] - mf[i]) * li[i] : 0.f; a += p; if (e == 3) b3 = p; }
                a += __shfl_xor(a, 4); a += __shfl_xor(a, 8); b3 += __shfl_xor(b3, 4); b3 += __shfl_xor(b3, 8);
                if (fr_i < 4) { const int jp = 16 * t + 4 * ss + fq_i;
                    __hip_atomic_fetch_add(imp + tok[i] * ISTR + jp, a, __ATOMIC_RELAXED, __HIP_MEMORY_SCOPE_WORKGROUP);
                    __hip_atomic_fetch_add(imp + tok[i] * ISTR + jp + 1, b3, __ATOMIC_RELAXED, __HIP_MEMORY_SCOPE_WORKGROUP); }
            }
        }
    }
#endif
    __syncthreads();
#ifndef NSA_NO_TOPK
    {
        int tid_k = tid; asm volatile("" : "+v"(tid_k)); const int tk = tid_k >> 3, part = tid_k & 7;
        float v[16]; int cnt[16];
#pragma unroll
        for (int jj = 0; jj < 16; ++jj) { const int j = part * 16 + jj; const bool causal = j <= qb, forced = (j == 0) || (j == qb) || (j == qb - 1);
            const float val = !causal ? -1.0f : (forced ? 1e9f : imp[tk * ISTR + j]); v[jj] = val; cnt[jj] = 0; }
        __syncthreads();
#pragma unroll
        for (int jj = 0; jj < 16; ++jj) imp[tk * ISTR + part * 16 + jj] = v[jj];
        __syncthreads();
        for (int k = 0; k <= qb; ++k) { const float vk = imp[tk * ISTR + k];
#pragma unroll
            for (int jj = 0; jj < 16; ++jj) { const int j = part * 16 + jj; cnt[jj] += ((vk > v[jj]) || (vk == v[jj] && k < j)) ? 1 : 0; } }
        unsigned bits = 0u;
#pragma unroll
        for (int jj = 0; jj < 16; ++jj) { const int j = part * 16 + jj; if (j <= qb && cnt[jj] < 16) bits |= (1u << jj); }
        ((LAS unsigned short*)(lds + OFF_SEL))[tk * 8 + part] = (unsigned short)bits;
    }
#endif
    __syncthreads();
#ifndef NSA_NO_SEL
    nsa_load_q(P.QN, b, g, tid, t0, qf);
    attn_pass<64, SEL>(lds, P.KV6 + 2 * KV6_SEG + bg * T * 64, 64, nullptr, 0, P.KV6 + 3 * KV6_SEG + bg * T * 64, 64, 0, qb, qf, tpos, tok, wave_tmin, wave_tmax, o, mf, li, tid, fr, fq);
#pragma unroll
    for (int i = 0; i < 2; ++i) { const float gs = P.GATES[((size_t)b * T + tpos[i]) * 24 + g * 12 + hh * 3 + 1];
#pragma unroll
        for (int dt = 0; dt < 4; ++dt) ocl[(i * 4 + dt) * NTHREADS + tid] += o[i][dt] * gs; }
#endif
    nsa_load_q(P.QN, b, g, tid, t0, qf);
    attn_pass<64, WINDOW>(lds, P.KV6 + 4 * KV6_SEG + bg * T * 64, 64, nullptr, 0, P.KV6 + 5 * KV6_SEG + bg * T * 64, 64, (qb >= 8 ? qb - 8 : 0), qb, qf, tpos, tok, wave_tmin, wave_tmax, o, mf, li, tid, fr, fq);
#pragma unroll
    for (int i = 0; i < 2; ++i) {
        const float gw = P.GATES[((size_t)b * T + tpos[i]) * 24 + g * 12 + hh * 3 + 2];
        bf16* orow = P.OCAT + ((size_t)b * T + tpos[i]) * 1024 + (g * 4 + hh) * 64 + 4 * fq;
#pragma unroll
        for (int dt = 0; dt < 4; ++dt) { const f32x4 r = ocl[(i * 4 + dt) * NTHREADS + tid] + o[i][dt] * gw;
            *(unsigned long long*)(orow + 16 * dt) = (unsigned long long)pk2(r[0], r[1]) | ((unsigned long long)pk2(r[2], r[3]) << 32); }
    }
}

struct MlaPtrs { const bf16 *QMLA, *KVMLA, *KR; bf16* OCAT; };
__device__ __forceinline__ void mla_item(LAS unsigned char* lds, const MlaPtrs& P, int b, int h, int qb, int tid) {
    const int wave = tid >> 6, lane = tid & 63, fr = lane & 15, fq = lane >> 4;
    const int t0 = 256 * qb;
    int tpos[2], tok[2]; bf16x8 qf[2][3];
#pragma unroll
    for (int i = 0; i < 2; ++i) {
        tok[i] = 0; tpos[i] = t0 + 32 * wave + 16 * i + fr;
        const bf16* qrow = P.QMLA + ((size_t)b * T + tpos[i]) * 768;
        qf[i][0] = *(const bf16x8*)(qrow + h * 64 + 8 * fq); qf[i][1] = *(const bf16x8*)(qrow + h * 64 + 32 + 8 * fq); qf[i][2] = *(const bf16x8*)(qrow + 512 + h * 32 + 8 * fq);
    }
    const int wave_tmin = t0 + 32 * wave, wave_tmax = t0 + 32 * wave + 31;
    f32x4 o[2][4]; float mf[2], li[2];
    const bf16* kv = P.KVMLA + (size_t)b * T * 1024;
    attn_pass<96, CAUSAL>(lds, kv + h * 64, 1024, P.KR + (size_t)b * T * 32, 32, kv + 512 + h * 64, 1024, 0, 4 * qb + 3, qf, tpos, tok, wave_tmin, wave_tmax, o, mf, li, tid, fr, fq);
#pragma unroll
    for (int i = 0; i < 2; ++i) {
        bf16* orow = P.OCAT + ((size_t)b * T + tpos[i]) * 1024 + 512 + h * 64 + 4 * fq;
#pragma unroll
        for (int dt = 0; dt < 4; ++dt) { const f32x4 r = o[i][dt];
            *(unsigned long long*)(orow + 16 * dt) = (unsigned long long)pk2(r[0], r[1]) | ((unsigned long long)pk2(r[2], r[3]) << 32); }
    }
}
}

__device__ __forceinline__ void tr_item(const float* W, int N, int k0, int n0, bf16* WT, int Kd, int drow0, int dk0, LAS float* scr, int lane) {
#pragma unroll 8
    for (int i = 0; i < 32; ++i) { const int kk = 2 * i + (lane >> 5); const int n = n0 + (lane & 31); scr[kk * 33 + (lane & 31)] = (n < N) ? W[(size_t)(k0 + kk) * N + n] : 0.f; }
    LDS_WAIT();
    const int c = lane & 7;
#pragma unroll
    for (int j = 0; j < 4; ++j) { const int n = (lane >> 3) + 8 * j; const LAS float* s = scr + (8 * c) * 33 + n;
        v4u o; o.x = pk2(s[0 * 33], s[1 * 33]); o.y = pk2(s[2 * 33], s[3 * 33]); o.z = pk2(s[4 * 33], s[5 * 33]); o.w = pk2(s[6 * 33], s[7 * 33]);
        *(v4u*)(WT + (size_t)(drow0 + n) * Kd + dk0 + 8 * c) = o; }
    LDS_WAIT();
}

template <bool DO_LN, bool DO_U> __device__ __forceinline__ void row_pass(const float* xin, float* xout, const float* lng, const float* lnb, const float* mod, int sh_off, int sc_off, bf16* U, int gw, int NGW, int lane) {
    for (int m = gw; m < M; m += NGW) {
        const int b = m >> 13;
        const f32x4* xr = (const f32x4*)(xin + (size_t)m * D) + lane;
        f32x4 v[4];
#pragma unroll
        for (int j = 0; j < 4; ++j) v[j] = xr[64 * j];
        if (DO_LN) {
            float s = 0.f;
#pragma unroll
            for (int j = 0; j < 4; ++j) s += (v[j].x + v[j].y) + (v[j].z + v[j].w);
            const float mean = wave_sum(s) * (1.f / D); float s2 = 0.f;
#pragma unroll
            for (int j = 0; j < 4; ++j) { v[j] = v[j] - mean; s2 += (v[j].x * v[j].x + v[j].y * v[j].y) + (v[j].z * v[j].z + v[j].w * v[j].w); }
            const float rstd = 1.f / sqrtf(wave_sum(s2) * (1.f / D) + LN_EPS);
            f32x4* xo = (f32x4*)(xout + (size_t)m * D) + lane;
#pragma unroll
            for (int j = 0; j < 4; ++j) { const f32x4 gg = *((const f32x4*)lng + lane + 64 * j), bb = *((const f32x4*)lnb + lane + 64 * j); v[j] = v[j] * rstd * gg + bb; xo[64 * j] = v[j]; }
        }
        if (DO_U) {
            const f32x4* shp = (const f32x4*)(mod + (size_t)b * NMOD + sh_off) + lane; const f32x4* scp = (const f32x4*)(mod + (size_t)b * NMOD + sc_off) + lane;
            unsigned long long* o8 = (unsigned long long*)(U + (size_t)m * D) + lane;
#pragma unroll
            for (int j = 0; j < 4; ++j) { const f32x4 u = v[j] * (scp[64 * j] + 1.0f) + shp[64 * j];
                o8[64 * j] = (unsigned long long)pk2(u.x, u.y) | ((unsigned long long)pk2(u.z, u.w) << 32); }
        }
    }
}

#define GAS __attribute__((address_space(1)))
#define XB_TMO      128
#define XB_XCNT(j)  (256  + 64 * (j))
#define XB_XSUB(j)  (1280 + 64 * (j))
#define XB_XGEN(j)  (2304 + 64 * (j))
#define XB_TOP      3328
#define XB_TOPGEN   3392
#define XCD_BAR_WORDS 3456
#define XB_SPIN_CAP (1u << 18)

__device__ __forceinline__ unsigned xb_ld(unsigned* p)              { return __hip_atomic_load(p, __ATOMIC_RELAXED, __HIP_MEMORY_SCOPE_AGENT); }
__device__ __forceinline__ unsigned xb_add(unsigned* p, unsigned v) { return __hip_atomic_fetch_add(p, v, __ATOMIC_RELAXED, __HIP_MEMORY_SCOPE_AGENT); }
__device__ __forceinline__ unsigned xb_xcc_id() { return (unsigned)__builtin_amdgcn_s_getreg((3 << 11) | 20) & 0xFu; }
#define XB_SPIN(cond, bar) do { unsigned _sp = 0; while (cond) { __builtin_amdgcn_s_sleep(1); \
    if ((++_sp & 255u) == 0u) { if (xb_ld(&(bar)[XB_TMO])) break; if (_sp > XB_SPIN_CAP) { atomicAdd(&(bar)[XB_TMO], 1u); break; } } } } while (0)

struct XcdBarrier {
    unsigned* bar; unsigned x;
    volatile LAS unsigned* st;
};

__device__ __forceinline__ XcdBarrier xcd_barrier_post(unsigned* bar, volatile LAS unsigned* st) {
    XcdBarrier b; b.bar = bar; b.x = xb_xcc_id(); b.st = st;
    if (threadIdx.x == 0) (void)xb_add(&bar[XB_XCNT(b.x)], 1u);
    return b;
}
__device__ __forceinline__ void xcd_barrier_complete(unsigned* bar, unsigned x, unsigned& nloc, unsigned& nx) {
    const unsigned G = gridDim.x * gridDim.y * gridDim.z;
    unsigned sum, cnt, mine, sp = 0u;
    for (;;) {
        sum = 0u; cnt = 0u; mine = 0u;
#pragma unroll
        for (unsigned j = 0; j < 16; ++j) { const unsigned c = xb_ld(&bar[XB_XCNT(j)]); sum += c; cnt += (c > 0u) ? 1u : 0u; mine = (j == x) ? c : mine; }
        if (sum == G) break;
        __builtin_amdgcn_s_sleep(1);
        if ((++sp & 255u) == 0u) { if (xb_ld(&bar[XB_TMO])) break; if (sp > XB_SPIN_CAP) { atomicAdd(&bar[XB_TMO], 1u); break; } }
    }
    nloc = mine > 0u ? mine : 1u; nx = cnt > 0u ? cnt : 1u;
}

__device__ __forceinline__ void xcd_barrier(const XcdBarrier& b) {
    asm volatile("s_waitcnt vmcnt(0)" ::: "memory");
    __syncthreads();
    if (threadIdx.x == 0) {
        unsigned* bar = b.bar;
        __builtin_amdgcn_s_waitcnt(0);
        unsigned nloc = b.st[0], nx = b.st[1];
        if (nloc == 0u) { xcd_barrier_complete(bar, b.x, nloc, nx); b.st[0] = nloc; b.st[1] = nx; }
        const unsigned old = xb_add(&bar[XB_XSUB(b.x)], 1u);
        const unsigned gen = old / nloc;
        if (old + 1u == (gen + 1u) * nloc) {
            __builtin_amdgcn_fence(__ATOMIC_RELEASE, "agent");
            asm volatile("s_waitcnt vmcnt(0)" ::: "memory");
            const unsigned og = xb_add(&bar[XB_TOP], 1u);
            const unsigned tg = og / nx;
            if (og + 1u == (tg + 1u) * nx) xb_add(&bar[XB_TOPGEN], 1u);
            else XB_SPIN(xb_ld(&bar[XB_TOPGEN]) == tg, bar);
            __builtin_amdgcn_fence(__ATOMIC_ACQUIRE, "agent");
            xb_add(&bar[XB_XGEN(b.x)], 1u);
            asm volatile("s_waitcnt vmcnt(0)" ::: "memory");
        } else {
            XB_SPIN(xb_ld(&bar[XB_XGEN(b.x)]) == gen, bar);
            __builtin_amdgcn_fence(__ATOMIC_ACQUIRE, "agent");
            asm volatile("s_waitcnt vmcnt(0)" ::: "memory");
        }
    }
    __syncthreads();
}

__global__ void __launch_bounds__(NTHREADS, 2) mega_fwd(Args a_unused) {
    extern __shared__ __attribute__((aligned(16))) unsigned char lds_raw[];
    cg::grid_group grid = cg::this_grid();
    (void)a_unused;
    { volatile LAS unsigned* misc = (volatile LAS unsigned*)((LAS unsigned char*)lds_raw + LDS_BYTES - 64);
      if (threadIdx.x < 16) misc[threadIdx.x] = 0u;
      __syncthreads();
      (void)xcd_barrier_post((unsigned*)((const Args*)__builtin_amdgcn_kernarg_segment_ptr())->ws + WS_CTL / 4, misc + 8); }
#define PH_BEGIN { const Args* ap = (const Args*)__builtin_amdgcn_kernarg_segment_ptr(); asm volatile("" : "+s"(ap)); unsigned char* ws; { const unsigned long long w_ = (unsigned long long)ap->ws; const unsigned lo_ = __builtin_amdgcn_readfirstlane((unsigned)w_), hi_ = __builtin_amdgcn_readfirstlane((unsigned)(w_ >> 32)); ws = (unsigned char*)(((unsigned long long)hi_ << 32) | lo_); } asm volatile("" : "+s"(ws)); \
    LAS unsigned char* lds = (LAS unsigned char*)lds_raw; const int tid = threadIdx.x, lane = tid & 63, wave = __builtin_amdgcn_readfirstlane(tid >> 6); \
    const int G = gridDim.x, bx = blockIdx.x, gw = bx * 8 + wave, NGW = G * 8; (void)lane; (void)gw; (void)NGW; (void)lds;
#define PH_END } { XcdBarrier b_; b_.bar = (unsigned*)((const Args*)__builtin_amdgcn_kernarg_segment_ptr())->ws + WS_CTL / 4; b_.x = xb_xcc_id(); b_.st = (volatile LAS unsigned*)((LAS unsigned char*)lds_raw + LDS_BYTES - 64) + 8; xcd_barrier(b_); }
#define mod ((float*)(ws + WS_MOD))
#define posb ((float*)(ws + WS_POSB))
#define CS8 ((float*)(ws + WS_CS8))
#define CS16 ((float*)(ws + WS_CS16))
#define Wgu1 ((bf16*)(ws + WS_WGU1))
#define Wd1 ((bf16*)(ws + WS_WD1))
#define Wgu2 ((bf16*)(ws + WS_WGU2))
#define Wd2 ((bf16*)(ws + WS_WD2))
#define Win ((bf16*)(ws + WS_WIN))
#define Wout ((bf16*)(ws + WS_WOUT))
#define Wuq ((bf16*)(ws + WS_WUQ))
#define Wukv ((bf16*)(ws + WS_WUKV))
#define W1k ((bf16*)(ws + WS_W1K))
#define W1v ((bf16*)(ws + WS_W1V))
#define KCMP ((bf16*)(ws + WS_KCMP))
#define VCMP ((bf16*)(ws + WS_VCMP))
#define YK ((float*)(ws + WS_YK))
#define YV ((float*)(ws + WS_YV))
#define GATES ((float*)(ws + WS_GATES))
#define KR ((bf16*)(ws + WS_KR))
#define U ((bf16*)(ws + WS_U))
#define HFF ((bf16*)(ws + WS_HFF))
#define H ((bf16*)(ws + WS_H))
#define QMLA ((bf16*)(ws + WS_QMLA))
#define KVMLA ((bf16*)(ws + WS_KVMLA))
#define QN ((bf16*)(ws + WS_QN))
#define KV6 ((bf16*)(ws + WS_KV6))
#define CQN ((bf16*)(ws + WS_CQN))
#define CKVN ((bf16*)(ws + WS_CKVN))
#define XIN (ap->in[0])
#define XOUT (ap->out)

    PH_BEGIN
    {
        LAS float* sc = (LAS float*)(lds + 131072);
        for (int i = tid; i < 2 * D; i += NTHREADS) { const float cv = ap->in[1][i]; sc[i] = cv / (1.f + expf(-cv)); }
        __syncthreads();
        LAS float* red = (LAS float*)lds;
        for (int cb = bx; cb < 256; cb += G) {
            const int col = tid % 36, kc = tid / 36, j = 36 * cb + col;
            if (kc < 14) {
                float a0 = 0.f, a1 = 0.f; const int k1 = (kc * 74 + 74 < D) ? kc * 74 + 74 : D;
                for (int k = kc * 74; k < k1; ++k) { const float w = ap->in[2][(size_t)k * NMOD + j]; a0 += sc[k] * w; a1 += sc[D + k] * w; }
                red[(kc * 36 + col) * 2] = a0; red[(kc * 36 + col) * 2 + 1] = a1;
            }
            __syncthreads();
            if (tid < 72) { const int c2 = tid >> 1, bb = tid & 1; float s = ap->in[3][36 * cb + c2];
                for (int q = 0; q < 14; ++q) s += red[(q * 36 + c2) * 2 + bb];
                mod[(size_t)bb * NMOD + 36 * cb + c2] = s; }
            __syncthreads();
        }
        for (int o = gw; o < 512; o += NGW) {
            const int which = o >> 8, j = o & 255; const float* pe = ap->in[which ? 13 : 10]; const float* w1 = ap->in[which ? 14 : 11];
            float s = 0.f;
            for (int k = lane; k < 2048; k += 64) s += pe[k] * w1[(size_t)k * 256 + j];
            s = wave_sum(s);
            if (lane == 0) posb[which * 256 + j] = s;
        }
        for (int e = bx * NTHREADS + tid; e < 8192 * 24; e += G * NTHREADS) {
            const int pos = e / 24, i = e % 24; double iv = 0.0;
#pragma unroll
            for (int q = 0; q < 8; ++q) if (i == q) iv = ap->inv8[q];
#pragma unroll
            for (int q = 0; q < 16; ++q) if (i == 8 + q) iv = ap->inv16[q];
            float c_, s_; rope_cs(pos, iv, c_, s_);
            if (i < 8) { CS8[pos * 16 + i] = c_; CS8[pos * 16 + 8 + i] = s_; } else { CS16[pos * 32 + (i - 8)] = c_; CS16[pos * 32 + 16 + (i - 8)] = s_; }
        }
        __syncthreads();
        LAS float* scr = (LAS float*)(lds + wave * 16384);
        constexpr int I_GU = (D / 64) * (FF / 32), I_WD = (FF / 64) * (D / 32), I_IN = (D / 64) * (DINP / 32), I_W1 = (2048 / 64) * (256 / 32), I_UQ = (384 / 64) * (768 / 32),
                      I_UKV = (256 / 64) * (1024 / 32), I_OUT = (D / 64) * (D / 32);
        constexpr int NITEMS = 4 * I_GU + 2 * I_WD + I_IN + 2 * I_W1 + I_UQ + I_UKV + I_OUT;
        for (int it = gw; it < NITEMS; it += NGW) {
            int r = it;
#define TR_TRY(CNT, NBLK, ...) if (r < (CNT)) { const int k0 = 64 * (r / (NBLK)), n0 = 32 * (r % (NBLK)); (void)k0; (void)n0; __VA_ARGS__; continue; } r -= (CNT);
            TR_TRY(I_GU, FF / 32, tr_item(ap->in[6], FF, k0, n0, Wgu1, D, (n0 / 128) * 256 + (n0 % 128), k0, scr, lane))
            TR_TRY(I_GU, FF / 32, tr_item(ap->in[7], FF, k0, n0, Wgu1, D, (n0 / 128) * 256 + 128 + (n0 % 128), k0, scr, lane))
            TR_TRY(I_WD, D / 32, tr_item(ap->in[8], D, k0, n0, Wd1, FF, n0, k0, scr, lane))
            TR_TRY(I_GU, FF / 32, tr_item(ap->in[21], FF, k0, n0, Wgu2, D, (n0 / 128) * 256 + (n0 % 128), k0, scr, lane))
            TR_TRY(I_GU, FF / 32, tr_item(ap->in[22], FF, k0, n0, Wgu2, D, (n0 / 128) * 256 + 128 + (n0 % 128), k0, scr, lane))
            TR_TRY(I_WD, D / 32, tr_item(ap->in[23], D, k0, n0, Wd2, FF, n0, k0, scr, lane))
            TR_TRY(I_IN, DINP / 32, tr_item(ap->in[9], DIN, k0, n0, Win, D, n0, k0, scr, lane))
            TR_TRY(I_W1, 256 / 32, tr_item(ap->in[11], 256, k0, n0, W1k, 1024, (k0 >= 1024 ? 256 : 0) + n0, k0 & 1023, scr, lane))
            TR_TRY(I_W1, 256 / 32, tr_item(ap->in[14], 256, k0, n0, W1v, 1024, (k0 >= 1024 ? 256 : 0) + n0, k0 & 1023, scr, lane))
            TR_TRY(I_UQ, 768 / 32, { const int hq = n0 / 96, jq = (n0 % 96) / 32; tr_item(ap->in[18], 768, k0, n0, Wuq, 384, jq < 2 ? hq * 64 + 32 * jq : 512 + hq * 32, k0, scr, lane); })
            TR_TRY(I_UKV, 1024 / 32, { const int hk = n0 / 128, ek = n0 % 128; tr_item(ap->in[19], 1024, k0, n0, Wukv, 256, ek < 64 ? hk * 64 + ek : 512 + hk * 64 + (ek - 64), k0, scr, lane); })
            TR_TRY(I_OUT, D / 32, tr_item(ap->in[20], D, k0, n0, Wout, D, n0, k0, scr, lane))
#undef TR_TRY
        }
    }
    } grid.sync();

    PH_BEGIN
    row_pass<false, true>(XIN, nullptr, nullptr, nullptr, mod, 0 * D, 1 * D, U, gw, NGW, lane);
    PH_END

    PH_BEGIN
#if !defined(ONLY_G) || ONLY_G == 1
    { int Kq = D; asm volatile("" : "+s"(Kq)); pg8::Gemm g{U, Wgu1, M, 2 * FF, Kq}; pg8::StaticOrder S; S.init(M, 2 * FF, G, bx); pg8::EpiSwiglu E{HFF, FF};
      pg8::gemm_phase<pg8::EpiSwiglu, pg8::StaticOrder, true, true>(lds, g, S, E); }
#endif
    PH_END
    PH_BEGIN
#if !defined(ONLY_G) || ONLY_G == 2
    { int Kq = FF; asm volatile("" : "+s"(Kq)); pg8::Gemm g{HFF, Wd1, M, D, Kq}; pg8::StaticOrder S; S.init(M, D, G, bx); pg8::EpiResid E{XIN, XOUT, mod + 2 * D, 0.5f};
      pg8::gemm_phase<pg8::EpiResid, pg8::StaticOrder, true, true>(lds, g, S, E); }
#endif
    PH_END
    PH_BEGIN
    row_pass<true, true>(XOUT, XOUT, ap->in[4] + 0 * D, ap->in[5] + 0 * D, mod, 3 * D, 4 * D, U, gw, NGW, lane);
    PH_END
    PH_BEGIN
#if !defined(ONLY_G) || ONLY_G == 3
    { int Kq = D; asm volatile("" : "+s"(Kq)); pg8::Gemm g{U, Win, M, DINP, Kq}; pg8::StaticOrder S; S.init(M, DINP, G, bx); pg8::EpiBf16<0> E{H, DINP, nullptr, 0, 0, 1.f};
      pg8::gemm_phase<pg8::EpiBf16<0>, pg8::StaticOrder, true, true>(lds, g, S, E); }
#endif
    PH_END
    PH_BEGIN
    {
        LAS v4u* rb = (LAS v4u*)(lds + wave * 4096); LAS unsigned short* hb = (LAS unsigned short*)rb;
        for (int m = gw; m < M; m += NGW) {
            const int b = m >> 13, t = m & 8191;
            const v4u* hr = (const v4u*)(H + (size_t)m * DINP);
#pragma unroll
            for (int j = 0; j < 4; ++j) rb[lane + 64 * j] = hr[lane + 64 * j];
            LDS_WAIT();
            {
                const int base = 8 * lane, d0 = 8 * (lane & 7); float v[8];
#pragma unroll
                for (int e = 0; e < 8; ++e) v[e] = bf2f(hb[base + e]);
                if (d0 < 16) {
#pragma unroll
                    for (int e = 0; e < 8; ++e) { const float c_ = CS8[t * 16 + e], s_ = CS8[t * 16 + 8 + e]; const float pr = bf2f(hb[base + e + (d0 == 0 ? 8 : -8)]); v[e] = (d0 == 0) ? v[e] * c_ - pr * s_ : v[e] * c_ + pr * s_; }
                }
                v4u o; o.x = pk2(v[0] * QS_NSA, v[1] * QS_NSA); o.y = pk2(v[2] * QS_NSA, v[3] * QS_NSA); o.z = pk2(v[4] * QS_NSA, v[5] * QS_NSA); o.w = pk2(v[6] * QS_NSA, v[7] * QS_NSA);
                *(v4u*)(QN + (size_t)m * 512 + base) = o;
            }
#pragma unroll
            for (int it = 0; it < 2; ++it) {
                const int ch = lane + 64 * it;
                if (ch < 96) {
                    const int seg = ch >> 4, w = ch & 15, g = w >> 3, d0 = 8 * (w & 7), base = 512 + 128 * seg + 64 * g + d0; float v[8];
#pragma unroll
                    for (int e = 0; e < 8; ++e) v[e] = bf2f(hb[base + e]);
                    if ((seg & 1) == 0 && d0 < 16) {
#pragma unroll
                        for (int e = 0; e < 8; ++e) { const float c_ = CS8[t * 16 + e], s_ = CS8[t * 16 + 8 + e]; const float pr = bf2f(hb[base + e + (d0 == 0 ? 8 : -8)]); v[e] = (d0 == 0) ? v[e] * c_ - pr * s_ : v[e] * c_ + pr * s_; }
                    }
                    v4u o; o.x = pk2(v[0], v[1]); o.y = pk2(v[2], v[3]); o.z = pk2(v[4], v[5]); o.w = pk2(v[6], v[7]);
                    *(v4u*)(KV6 + (size_t)seg * KV6_SEG + ((size_t)(b * 2 + g) * T + t) * 64 + d0) = o;
                }
            }
            if (lane < 24) GATES[(size_t)m * 24 + lane] = 1.f / (1.f + expf(-bf2f(hb[1280 + lane])));
            {
                float xv[6]; float ss = 0.f;
#pragma unroll
                for (int j = 0; j < 3; ++j) { xv[2 * j] = bf2f(hb[1304 + 2 * lane + 128 * j]); xv[2 * j + 1] = bf2f(hb[1304 + 2 * lane + 128 * j + 1]); ss += xv[2 * j] * xv[2 * j] + xv[2 * j + 1] * xv[2 * j + 1]; }
                const float r = 1.f / sqrtf(wave_sum(ss) * (1.f / 384.f) + LN_EPS);
#pragma unroll
                for (int j = 0; j < 3; ++j) { const int i = 2 * lane + 128 * j; *(unsigned*)(CQN + (size_t)m * 384 + i) = pk2(xv[2 * j] * r * ap->in[16][i], xv[2 * j + 1] * r * ap->in[16][i + 1]); }
            }
            {
                float xv[4]; float ss = 0.f;
#pragma unroll
                for (int j = 0; j < 2; ++j) { xv[2 * j] = bf2f(hb[1688 + 2 * lane + 128 * j]); xv[2 * j + 1] = bf2f(hb[1688 + 2 * lane + 128 * j + 1]); ss += xv[2 * j] * xv[2 * j] + xv[2 * j + 1] * xv[2 * j + 1]; }
                const float r = 1.f / sqrtf(wave_sum(ss) * (1.f / 256.f) + LN_EPS);
#pragma unroll
                for (int j = 0; j < 2; ++j) { const int i = 2 * lane + 128 * j; *(unsigned*)(CKVN + (size_t)m * 256 + i) = pk2(xv[2 * j] * r * ap->in[17][i], xv[2 * j + 1] * r * ap->in[17][i + 1]); }
            }
            if (lane < 32) {
                const float xs = bf2f(hb[1944 + lane]), pr = bf2f(hb[1944 + (lane ^ 16)]); const float c_ = CS16[t * 32 + (lane & 15)], s_ = CS16[t * 32 + 16 + (lane & 15)];
                const float r = (lane < 16) ? xs * c_ - pr * s_ : xs * c_ + pr * s_;
                KR[(size_t)m * 32 + lane] = (bf16)f2bf(r);
            }
            LDS_WAIT(); asm volatile("" ::: "memory");
        }
    }
    PH_END
    PH_BEGIN
#if !defined(ONLY_G) || ONLY_G == 4
    { int Kq = 384; asm volatile("" : "+s"(Kq)); pg8::Gemm g{CQN, Wuq, M, 768, Kq}; pg8::StaticOrder S; S.init(M, 768, G, bx); pg8::EpiQmla E{QMLA, CS16};
      pg8::gemm_phase<pg8::EpiQmla, pg8::StaticOrder, true, true>(lds, g, S, E); }
#endif
#if !defined(ONLY_G) || ONLY_G == 5
    { int Kq = 1024; asm volatile("" : "+s"(Kq)); pg8::Gemm g{KV6 + 0 * KV6_SEG, W1k, 2048, 512, Kq}; pg8::StaticOrder S; S.init(2048, 512, G, (bx + G - 192 % G) % G); pg8::EpiF32 E{YK, 512};
      pg8::gemm_phase<pg8::EpiF32, pg8::StaticOrder, true, true>(lds, g, S, E); }
#endif
#if !defined(ONLY_G) || ONLY_G == 6
    { int Kq = 1024; asm volatile("" : "+s"(Kq)); pg8::Gemm g{KV6 + 1 * KV6_SEG, W1v, 2048, 512, Kq}; pg8::StaticOrder S; S.init(2048, 512, G, (bx + G - 208 % G) % G); pg8::EpiF32 E{YV, 512};
      pg8::gemm_phase<pg8::EpiF32, pg8::StaticOrder, true, true>(lds, g, S, E); }
#endif
#if !defined(ONLY_G) || ONLY_G == 7
    { int Kq = 256; asm volatile("" : "+s"(Kq)); pg8::Gemm g{CKVN, Wukv, M, 1024, Kq}; pg8::StaticOrder S; S.init(M, 1024, G, bx); pg8::EpiBf16<0> E{KVMLA, 1024, nullptr, 0, 0, 1.f};
      pg8::gemm_phase<pg8::EpiBf16<0>, pg8::StaticOrder, true, true>(lds, g, S, E); }
#endif
    PH_END
    PH_BEGIN
    {
        LAS float* hbuf = (LAS float*)(lds + wave * 1024);
        for (int idx = gw; idx < 2 * 4 * 512; idx += NGW) {
            const int kv = idx >> 11, bg = (idx >> 9) & 3, n = idx & 511;
            bf16* dst = (kv ? VCMP : KCMP) + ((size_t)bg * 512 + n) * 64;
            if (n == 511) { dst[lane] = 0; continue; }
            const float* Y = kv ? YV : YK; const float* pb = posb + kv * 256; const float* w2 = ap->in[kv ? 15 : 12];
#pragma unroll
            for (int i = 0; i < 4; ++i) { const int j = lane + 64 * i; const float p = Y[((size_t)bg * 512 + n) * 512 + j] + Y[((size_t)bg * 512 + n + 1) * 512 + 256 + j] + pb[j];
                const float y = 0.7978845608028654f * (p + 0.044715f * p * p * p); const float th = 1.f - 2.f / (expf(2.f * y) + 1.f); hbuf[j] = 0.5f * p * (1.f + th); }
            LDS_WAIT();
            float acc = 0.f;
#pragma unroll 8
            for (int j = 0; j < 256; ++j) acc += hbuf[j] * w2[j * 64 + lane];
            dst[lane] = (bf16)f2bf(acc);
            LDS_WAIT(); asm volatile("" ::: "memory");
        }
    }
    PH_END
    PH_BEGIN
    {
#ifndef NO_ATT
        for (int pi = bx; pi < 256; pi += G) {
#ifndef REP_MLA
#define REP_MLA 1
#endif
#ifndef REP_NSA
#define REP_NSA 1
#endif
#pragma nounroll
            for (int rep = 0; rep < 2 * REP_MLA; ++rep) {
                unsigned char* w2 = ws; asm volatile("" : "+s"(w2));
                const att::MlaPtrs MP{(const bf16*)(w2 + WS_QMLA), (const bf16*)(w2 + WS_KVMLA), (const bf16*)(w2 + WS_KR), (bf16*)(w2 + WS_U)};
                const int bh = pi >> 4, s = pi & 15; att::mla_item(lds, MP, bh >> 3, bh & 7, (rep & 1) ? s : 31 - s, tid);
            }
#ifndef NO_NSA
#pragma nounroll
            for (int rep = 0; rep < 2 * REP_NSA; ++rep) {
                unsigned char* w2 = ws; asm volatile("" : "+s"(w2));
                const att::NsaPtrs NP{(const bf16*)(w2 + WS_QN), (const bf16*)(w2 + WS_KV6), (const bf16*)(w2 + WS_KCMP), (const bf16*)(w2 + WS_VCMP), (const float*)(w2 + WS_GATES), (bf16*)(w2 + WS_U)};
                const int bg = pi >> 6, s = pi & 63; att::nsa_item(lds, NP, bg >> 1, bg & 1, (rep & 1) ? s : 127 - s, tid);
            }
#endif
        }
#endif
    }
    PH_END
    PH_BEGIN
#if !defined(ONLY_G) || ONLY_G == 8
    { int Kq = D; asm volatile("" : "+s"(Kq)); pg8::Gemm g{U, Wout, M, D, Kq}; pg8::StaticOrder S; S.init(M, D, G, bx); pg8::EpiResid E{XOUT, XOUT, mod + 5 * D, 1.0f};
      pg8::gemm_phase<pg8::EpiResid, pg8::StaticOrder, true, true>(lds, g, S, E); }
#endif
    PH_END
    PH_BEGIN
    row_pass<true, true>(XOUT, XOUT, ap->in[4] + 1 * D, ap->in[5] + 1 * D, mod, 6 * D, 7 * D, U, gw, NGW, lane);
    PH_END
    PH_BEGIN
#if !defined(ONLY_G) || ONLY_G == 9
    { int Kq = D; asm volatile("" : "+s"(Kq)); pg8::Gemm g{U, Wgu2, M, 2 * FF, Kq}; pg8::StaticOrder S; S.init(M, 2 * FF, G, bx); pg8::EpiSwiglu E{HFF, FF};
      pg8::gemm_phase<pg8::EpiSwiglu, pg8::StaticOrder, true, true>(lds, g, S, E); }
#endif
    PH_END
    PH_BEGIN
#if !defined(ONLY_G) || ONLY_G == 10
    { int Kq = FF; asm volatile("" : "+s"(Kq)); pg8::Gemm g{HFF, Wd2, M, D, Kq}; pg8::StaticOrder S; S.init(M, D, G, bx); pg8::EpiResid E{XOUT, XOUT, mod + 8 * D, 0.5f};
      pg8::gemm_phase<pg8::EpiResid, pg8::StaticOrder, true, true>(lds, g, S, E); }
#endif
    PH_END
#ifdef REP_SYNC
    for (int r_ = 0; r_ < REP_SYNC; ++r_) { PH_BEGIN PH_END }
#endif
    PH_BEGIN
    row_pass<true, false>(XOUT, XOUT, ap->in[4] + 2 * D, ap->in[5] + 2 * D, mod, 0, 0, U, gw, NGW, lane);
    }
}

#undef PH_BEGIN
#undef PH_END
#undef mod
#undef posb
#undef CS8
#undef CS16
#undef Wgu1
#undef Wd1
#undef Wgu2
#undef Wd2
#undef Win
#undef Wout
#undef Wuq
#undef Wukv
#undef W1k
#undef W1v
#undef KCMP
#undef VCMP
#undef YK
#undef YV
#undef GATES
#undef KR
#undef U
#undef HFF
#undef H
#undef QMLA
#undef KVMLA
#undef QN
#undef KV6
#undef CQN
#undef CKVN
#undef XIN
#undef XOUT

extern "C" void kernel_launch(void* const* d_in, const int* in_sizes, int n_in, void* d_out, int out_size, void* d_ws, size_t ws_size, hipStream_t stream) {
    static int grid = 0;
    if (grid == 0) {
        if (n_in != 24 || ws_size < WS_END) { fprintf(stderr, "kernel_launch: unexpected inputs (n_in %d, ws %zu)\n", n_in, ws_size); grid = -1; return; }
        int dev = 0, cus = 0, per_cu = 0;
        (void)hipGetDevice(&dev); (void)hipDeviceGetAttribute(&cus, hipDeviceAttributeMultiprocessorCount, dev);
        (void)hipFuncSetAttribute((const void*)mega_fwd, hipFuncAttributeMaxDynamicSharedMemorySize, LDS_BYTES);
        if (hipOccupancyMaxActiveBlocksPerMultiprocessor(&per_cu, (const void*)mega_fwd, NTHREADS, LDS_BYTES) != hipSuccess || per_cu < 1) { fprintf(stderr, "kernel_launch: occupancy query says %d\n", per_cu); per_cu = 1; }
        (void)hipGetLastError();
        grid = cus * per_cu;
    }
    if (grid < 0) return;
    Args a{};
    for (int i = 0; i < 24; ++i) a.in[i] = (const float*)d_in[i];
    a.out = (float*)d_out; a.ws = (unsigned char*)d_ws;
    const double two_pi = 6.283185307179586476925286766559;
    for (int i = 0; i < 8; ++i) a.inv8[i] = pow(500000.0, -(double)i / 8.0) / two_pi;
    for (int i = 0; i < 16; ++i) a.inv16[i] = pow(500000.0, -(double)i / 16.0) / two_pi;
    if (hipMemsetAsync((unsigned char*)d_ws + WS_CTL, 0, CTL_BYTES, stream) != hipSuccess) { fprintf(stderr, "kernel_launch: memset failed\n"); return; }
    void* args[] = {&a};
    hipError_t e = hipLaunchCooperativeKernel((const void*)mega_fwd, dim3(grid), dim3(NTHREADS), args, LDS_BYTES, stream);
    if (e != hipSuccess) fprintf(stderr, "cooperative launch failed: %s (grid %d)\n", hipGetErrorString(e), grid);
}
```
